# Optimizing an MI355X kernel written in HIP

```python
import math
import jax, jax.numpy as jnp
from jax import lax
import numpy as np

D_MODEL = 1024
BATCH = 16
SEQ = 2048
DEPTH = 1

D_MIX = D_MODEL
SB_HEADS = 8
HEAD_DIM = 64
SB_WIDTH = SB_HEADS * HEAD_DIM
CONV_GROUPS = 8
CONV_WIDTH = D_MIX - SB_WIDTH
CONV_K = 3
SB_BLOCK = 128
N_KEYS = 128
N_EXPERTS = N_KEYS * N_KEYS
PEER_HEADS = 8
PEER_DK = 256
D_HALF = PEER_DK // 2
PEER_TOPK = 16
PEER_CHUNK = 128
EPS = 1e-6

kernel_name = "hymba_sb_conv_peer_block"


def rmsnorm(x, g):
    xf = x.astype(jnp.float32)
    y = xf * lax.rsqrt(jnp.mean(xf * xf, axis=-1, keepdims=True) + EPS)
    return (y * g.astype(jnp.float32)).astype(x.dtype)


def stick_breaking_attention(q, k, v):
    S = q.shape[2]
    scale = 1.0 / math.sqrt(q.shape[-1])
    outs = []
    for i in range(S // SB_BLOCK):
        t0 = i * SB_BLOCK
        L = t0 + SB_BLOCK
        qb = q[:, :, t0:L].astype(jnp.float32)
        kb = k[:, :, :L].astype(jnp.float32)
        vb = v[:, :, :L].astype(jnp.float32)
        z = jnp.einsum('bhqd,bhkd->bhqk', qb, kb) * scale
        t_pos = t0 + jnp.arange(SB_BLOCK)[:, None]
        s_pos = jnp.arange(L)[None, :]
        mask = s_pos < t_pos
        log_1m = jnp.where(mask, jax.nn.log_sigmoid(-z), 0.0)
        suffix = lax.cumsum(log_1m, axis=3, reverse=True) - log_1m
        a = jnp.where(mask, jnp.exp(jax.nn.log_sigmoid(z) + suffix), 0.0)
        outs.append(jnp.einsum('bhqk,bhkd->bhqd', a, vb))
    return jnp.concatenate(outs, axis=2).astype(q.dtype)


def short_gated_conv(gb, gc, hc, conv_w, conv_b):
    S = hc.shape[1]
    u = gc * hc
    up = jnp.pad(u, ((0, 0), (CONV_K - 1, 0), (0, 0)))
    y = sum(conv_w[j] * up[:, j:j + S] for j in range(CONV_K)) + conv_b
    return gb * y


def peer(xn, wq, keys, u_tab, v_tab):
    B, S, D = xn.shape
    xt = xn.reshape(-1, PEER_CHUNK, D)

    def chunk(xc):
        q = (xc @ wq).reshape(PEER_CHUNK, PEER_HEADS, PEER_DK).astype(jnp.float32)
        s1 = jnp.einsum('thd,hnd->thn', q[..., :D_HALF], keys[0].astype(jnp.float32))
        s2 = jnp.einsum('thd,hnd->thn', q[..., D_HALF:], keys[1].astype(jnp.float32))
        v1, i1 = lax.top_k(s1, PEER_TOPK)
        v2, i2 = lax.top_k(s2, PEER_TOPK)
        cand = (v1[..., :, None] + v2[..., None, :]).reshape(PEER_CHUNK, PEER_HEADS, PEER_TOPK * PEER_TOPK)
        cand_idx = (i1[..., :, None] * N_KEYS + i2[..., None, :]).reshape(PEER_CHUNK, PEER_HEADS, PEER_TOPK * PEER_TOPK)
        best, pos = lax.top_k(cand, PEER_TOPK)
        idx = jnp.take_along_axis(cand_idx, pos, axis=-1)
        g = jax.nn.softmax(best, axis=-1)
        u = u_tab[idx]
        act = jax.nn.gelu(jnp.einsum('td,thkd->thk', xc, u))
        w = g.astype(xc.dtype) * act
        return jnp.einsum('thk,thkd->td', w, v_tab[idx])

    return lax.map(chunk, xt).reshape(B, S, D)


def setup_inputs(seed: int = 0) -> dict:
    key = jax.random.key(seed)
    ks = jax.random.split(key, 14)
    f32 = jnp.float32
    nrm = lambda k, shape, s: jax.random.normal(k, shape, f32) * s
    gain = lambda k, shape: 1.0 + 0.02 * jax.random.normal(k, shape, f32)
    return {
        "x": jax.random.normal(ks[0], (BATCH, SEQ, D_MODEL), f32),
        "mix_norm_g": gain(ks[1], (DEPTH, D_MODEL)),
        "w_in": nrm(ks[2], (DEPTH, D_MODEL, 3 * SB_WIDTH + 3 * CONV_WIDTH), D_MODEL ** -0.5),
        "conv_w": nrm(ks[3], (DEPTH, CONV_K, CONV_WIDTH), 0.5),
        "conv_b": nrm(ks[4], (DEPTH, CONV_WIDTH), 0.02),
        "attn_out_g": gain(ks[5], (DEPTH, SB_WIDTH)),
        "conv_out_g": gain(ks[6], (DEPTH, CONV_WIDTH)),
        "w_out": nrm(ks[7], (DEPTH, D_MIX, D_MODEL), D_MIX ** -0.5),
        "ffn_norm_g": gain(ks[8], (DEPTH, D_MODEL)),
        "peer_wq": nrm(ks[9], (DEPTH, D_MODEL, PEER_HEADS * PEER_DK), D_MODEL ** -0.5),
        "peer_keys": nrm(ks[10], (DEPTH, 2, PEER_HEADS, N_KEYS, D_HALF), D_HALF ** -0.5),
        "peer_u": nrm(ks[11], (DEPTH, N_EXPERTS, D_MODEL), D_MODEL ** -0.5),
        "peer_v": nrm(ks[12], (DEPTH, N_EXPERTS, D_MODEL), 0.5),
        "final_norm_g": gain(ks[13], (D_MODEL,)),
    }


def reference(x, mix_norm_g, w_in, conv_w, conv_b, attn_out_g, conv_out_g, w_out,
              ffn_norm_g, peer_wq, peer_keys, peer_u, peer_v, final_norm_g):
    B, S, D = x.shape
    for layer in range(DEPTH):
        h = rmsnorm(x, mix_norm_g[layer])
        proj = h @ w_in[layer]
        q, k, v, gb, gc, hc = jnp.split(proj, 6, axis=-1)
        heads = lambda t: t.reshape(B, S, SB_HEADS, HEAD_DIM).transpose(0, 2, 1, 3)
        o_attn = stick_breaking_attention(heads(q), heads(k), heads(v))
        o_attn = o_attn.transpose(0, 2, 1, 3).reshape(B, S, SB_WIDTH)
        o_conv = short_gated_conv(gb, gc, hc, conv_w[layer], conv_b[layer])
        mixed = jnp.concatenate([rmsnorm(o_attn, attn_out_g[layer]),
                                 rmsnorm(o_conv, conv_out_g[layer])], axis=-1)
        x = x + mixed @ w_out[layer]
        xn = rmsnorm(x, ffn_norm_g[layer])
        x = x + peer(xn, peer_wq[layer], peer_keys[layer], peer_u[layer], peer_v[layer])
    return rmsnorm(x, final_norm_g)
```

```cpp
#include <hip/hip_runtime.h>
#include <cstdio>
#include <cstdint>
namespace pg8 {
#define PG8_LAS __attribute__((address_space(3)))
typedef unsigned short bf16_t;
typedef short bf16x8 __attribute__((ext_vector_type(8)));
typedef float f32x4 __attribute__((ext_vector_type(4)));
typedef unsigned u32x4 __attribute__((ext_vector_type(4)));
constexpr int BM = 256, BK = 64, HALF = 128, HTB = HALF * BK * 2  , STAGE_BYTES = 8 * HTB, NXCD = 8, WGM = 8;

__host__ __device__ __forceinline__ int lds_byte(int r, int c) { const int st = (r >> 4) * 2 + (c >> 5), rr = r & 15, cc = c & 31, ob = rr * 64 + cc * 2; return st * 1024 + (ob ^ (((ob >> 9) & 1) << 5)); }
__host__ __device__ __forceinline__ void stage_rc(int b, int& R, int& C) { const int st = b / 1024, sb = b % 1024, swz = sb ^ (((sb >> 9) & 1) << 5); R = (st >> 1) * 16 + swz / 64; C = (st & 1) * 32 + (swz % 64) / 2; }
__host__ __device__ __forceinline__ int perm32(int rho) { const int n = rho >> 4, i = rho & 15; return 8 * (i >> 2) + 4 * n + (i & 3); }

struct Unit { int pm, pn; };
struct Gemm { const bf16_t* A; const bf16_t* Bt; int M, N, K; };

struct StaticOrder {
    int nM, nN, nwg, G, c;
    __host__ __device__ void init(int M, int N, int G_, int c_) { nM = M / BM; nN = N / BM; nwg = nM * nN; G = G_; c = c_; }
    __host__ __device__ bool next(int i, Unit& u) const {
        const long L = (long)i * G + c; if (L >= nwg) return false;
        int wgid = (int)L; { const int q = nwg / NXCD, r = nwg % NXCD, xcd = wgid % NXCD, off = wgid / NXCD; wgid = (xcd < r ? xcd * (q + 1) : r * (q + 1) + (xcd - r) * q) + off; }
        const int nig = WGM * nN, gid = wgid / nig, fm = gid * WGM, gsz = (nM - fm) < WGM ? (nM - fm) : WGM;
        u.pm = fm + ((wgid % nig) % gsz); u.pn = (wgid % nig) / gsz; return true;
    }
    __device__ __forceinline__ void a_ready(const Unit&) const {}
    __device__ __forceinline__ void done(const Unit&) const {}
};

__device__ __forceinline__ unsigned cvt_pk_bf16(float lo, float hi) { unsigned r; asm volatile("v_cvt_pk_bf16_f32 %0, %1, %2" : "=v"(r) : "v"(lo), "v"(hi)); return r; }
typedef float f32x2 __attribute__((ext_vector_type(2)));
__device__ __forceinline__ f32x2 gelu_pk(f32x2 v) {
    const f32x2 av = __builtin_elementwise_abs(v), d = av * 0.2316418882f + 1.0f;
    f32x2 t; t.x = __builtin_amdgcn_rcpf(d.x); t.y = __builtin_amdgcn_rcpf(d.y);
    f32x2 q = t * 0.5307027145f + (-0.7265760135f); q = q * t + 0.7107068705f; q = q * t + (-0.142248368f); q = q * t + 0.127414796f; q = q * t;
    const f32x2 s = (v * v) * (-0.72134752044f);
    f32x2 e; e.x = __builtin_amdgcn_exp2f(s.x); e.y = __builtin_amdgcn_exp2f(s.y);
    const f32x2 m = v * (q * e), r = v - m;
    f32x2 o; o.x = v.x < 0.f ? m.x : r.x; o.y = v.y < 0.f ? m.y : r.y; return o;
}

template <int ACT  > struct EpiBf16 {
    static constexpr bool PERM = true, AFTER_DRAIN = false; static_assert(ACT == 0 || ACT == 1, "EpiBf16: ACT is 0 (none) or 1 (gelu_pk)");
    bf16_t* O; int ldc; const float* bias; int split_cols; size_t split_stride; float scale0;
    __device__ __forceinline__ void operator()(const f32x4 (&acc)[2][2][4][2], const Unit& u, int wr, int wc, int fr, int fq) const {
        const int row0 = u.pm * BM + wr * 64 + fr; int colt = u.pn * BM; bf16_t* base = O;
        float sc = 1.f; if (split_cols) { const int t = colt / split_cols; base += (size_t)t * split_stride; colt -= t * split_cols; if (t == 0) sc = scale0; }
        const int col0 = colt + wc * 32 + 8 * fq, bcol0 = u.pn * BM + wc * 32 + 8 * fq;
        f32x4 bv[2][2];
#pragma unroll
        for (int bj = 0; bj < 2; ++bj)
#pragma unroll
            for (int n = 0; n < 2; ++n) bv[bj][n] = bias ? *(const f32x4*)(bias + bcol0 + bj * HALF + 4 * n) : (f32x4){0.f, 0.f, 0.f, 0.f};
#pragma unroll
        for (int ai = 0; ai < 2; ++ai)
#pragma unroll
            for (int m = 0; m < 4; ++m) { bf16_t* rowp = base + (size_t)(row0 + ai * HALF + m * 16) * ldc + col0;
#pragma unroll
                for (int bj = 0; bj < 2; ++bj) { f32x4 v0 = acc[ai][bj][m][0] + bv[bj][0], v1 = acc[ai][bj][m][1] + bv[bj][1];
                    if (ACT == 1) { f32x2 a = gelu_pk((f32x2){v0[0], v0[1]}), b = gelu_pk((f32x2){v0[2], v0[3]}), c = gelu_pk((f32x2){v1[0], v1[1]}), d = gelu_pk((f32x2){v1[2], v1[3]});
                        v0 = (f32x4){a.x, a.y, b.x, b.y}; v1 = (f32x4){c.x, c.y, d.x, d.y}; }
                    v0 = v0 * sc; v1 = v1 * sc; u32x4 w; w.x = cvt_pk_bf16(v0[0], v0[1]); w.y = cvt_pk_bf16(v0[2], v0[3]); w.z = cvt_pk_bf16(v1[0], v1[1]); w.w = cvt_pk_bf16(v1[2], v1[3]);
                    *(u32x4*)(rowp + bj * HALF) = w; } }
    }
};
typedef unsigned u32x2 __attribute__((ext_vector_type(2)));
struct EpiResid {
    static constexpr bool PERM = false, AFTER_DRAIN = false;
    const float* X; float* X1; bf16_t* XG; const float* g2; float* ssq; int ldc;
    __device__ __forceinline__ void operator()(const f32x4 (&acc)[2][2][4][2], const Unit& u, int wr, int wc, int fr, int fq) const {
        const int row0 = u.pm * BM + wr * 64 + fr, col0 = u.pn * BM + wc * 32 + 4 * fq;
        f32x4 gv[2][2];
#pragma unroll
        for (int bj = 0; bj < 2; ++bj)
#pragma unroll
            for (int n = 0; n < 2; ++n) gv[bj][n] = *(const f32x4*)(g2 + col0 + bj * HALF + n * 16);
#pragma unroll
        for (int ai = 0; ai < 2; ++ai)
#pragma unroll
            for (int m = 0; m < 4; ++m) { const int row = row0 + ai * HALF + m * 16; const size_t off = (size_t)row * ldc + col0; float s = 0.f;
#pragma unroll
                for (int bj = 0; bj < 2; ++bj)
#pragma unroll
                    for (int n = 0; n < 2; ++n) { const f32x4 xv = *(const f32x4*)(X + off + bj * HALF + n * 16); const f32x4 v = xv + acc[ai][bj][m][n];
                        *(f32x4*)(X1 + off + bj * HALF + n * 16) = v; s += (v[0] * v[0] + v[1] * v[1]) + (v[2] * v[2] + v[3] * v[3]);
                        const f32x4 w = v * gv[bj][n]; u32x2 pk; pk.x = cvt_pk_bf16(w[0], w[1]); pk.y = cvt_pk_bf16(w[2], w[3]); *(u32x2*)(XG + off + bj * HALF + n * 16) = pk; }
                s += __shfl_xor(s, 16); s += __shfl_xor(s, 32);
                if (fq == 0) __hip_atomic_fetch_add(ssq + row, s, __ATOMIC_RELAXED, __HIP_MEMORY_SCOPE_AGENT);
                asm volatile("" ::: "memory"); }
    }
};
struct EpiBf16Rs {
    static constexpr bool PERM = true, AFTER_DRAIN = false;
    bf16_t* O; int ldc; const float* ssq; float inv_n, eps;
    __device__ __forceinline__ void operator()(const f32x4 (&acc)[2][2][4][2], const Unit& u, int wr, int wc, int fr, int fq) const {
        const int row0 = u.pm * BM + wr * 64 + fr, col0 = u.pn * BM + wc * 32 + 8 * fq;
#pragma unroll
        for (int ai = 0; ai < 2; ++ai)
#pragma unroll
            for (int m = 0; m < 4; ++m) { const int row = row0 + ai * HALF + m * 16; const float sc = rsqrtf(ssq[row] * inv_n + eps); bf16_t* rowp = O + (size_t)row * ldc + col0;
#pragma unroll
                for (int bj = 0; bj < 2; ++bj) { const f32x4 v0 = acc[ai][bj][m][0] * sc, v1 = acc[ai][bj][m][1] * sc;
                    u32x4 w; w.x = cvt_pk_bf16(v0[0], v0[1]); w.y = cvt_pk_bf16(v0[2], v0[3]); w.z = cvt_pk_bf16(v1[0], v1[1]); w.w = cvt_pk_bf16(v1[2], v1[3]);
                    *(u32x4*)(rowp + bj * HALF) = w; } }
    }
};
template <class Epi, class Sched, bool ALIGN_EPI = false, bool SP2 = false>
__device__ __forceinline__ void gemm_phase(PG8_LAS unsigned char* lds, const Gemm g, const Sched& S, const Epi& E) {
    const int tid = threadIdx.x, wid = __builtin_amdgcn_readfirstlane(tid >> 6), lane = tid & 63, wr = wid >> 2, wc = wid & 3, fr = lane & 15, fq = lane >> 4;
    const int K = g.K, nt = K / BK;
    unsigned voffA[2], voffB[2];
#pragma unroll
    for (int i = 0; i < 2; ++i) { int R, C; stage_rc(tid * 16 + i * 8192, R, C); const int Rb = Epi::PERM ? ((R & ~31) + perm32(R & 31)) : R;
        voffA[i] = (unsigned)(R * K + C) * 2u; voffB[i] = (unsigned)(Rb * K + C) * 2u; }
    const size_t kstep = (size_t)(BK * 2);
    const size_t hstep = (size_t)HALF * K * 2;
    const size_t tstep = 2 * hstep;
    const unsigned ldsw = (unsigned)wid * 1024u;
    const int aoff = lds_byte(wr * 64 + fr, fq * 8), boff = lds_byte(wc * 32 + fr, fq * 8);
#define PG8_SA(b, h) (((b) * 2 + (h)) * HTB)
#define PG8_SB(b, h) ((4 + (b) * 2 + (h)) * HTB)
#define PG8_STAGE(bufoff, gbase, voff) do { _Pragma("unroll") for (int _i = 0; _i < 2; ++_i) \
        __builtin_amdgcn_global_load_lds((const unsigned*)((const char*)(gbase) + (voff)[_i]), (PG8_LAS unsigned*)(lds + (bufoff) + ldsw + _i * 8192), 16, 0, 0); } while (0)
#define PG8_LDA(dst, b, h) do { _Pragma("unroll") for (int m = 0; m < 4; ++m) _Pragma("unroll") for (int k = 0; k < 2; ++k) dst[m][k] = *(const PG8_LAS bf16x8*)(lds + PG8_SA(b, h) + aoff + m * 2048 + k * 1024); } while (0)
#define PG8_LDB(dst, b, h) do { _Pragma("unroll") for (int n = 0; n < 2; ++n) _Pragma("unroll") for (int k = 0; k < 2; ++k) dst[n][k] = *(const PG8_LAS bf16x8*)(lds + PG8_SB(b, h) + boff + n * 2048 + k * 1024); } while (0)
#define PG8_MMA(ai, bj, At, Bt) do { __builtin_amdgcn_s_setprio(1); _Pragma("unroll") for (int m = 0; m < 4; ++m) _Pragma("unroll") for (int n = 0; n < 2; ++n) _Pragma("unroll") for (int k = 0; k < 2; ++k) \
        acc[ai][bj][m][n] = __builtin_amdgcn_mfma_f32_16x16x32_bf16(Bt[n][k], At[m][k], acc[ai][bj][m][n], 0, 0, 0); __builtin_amdgcn_s_setprio(0); } while (0)
#define PG8_WAIT_V(n) asm volatile("s_waitcnt vmcnt(" #n ")" ::: "memory")
#define PG8_WAIT_L(n) asm volatile("s_waitcnt lgkmcnt(" #n ")" ::: "memory")
#define PG8_BAR __builtin_amdgcn_s_barrier()
#define PG8_SCHED __builtin_amdgcn_sched_barrier(0)
    Unit cur, nxt; int ui = 0;
    if (!S.next(0, cur)) return;
    f32x4 acc[2][2][4][2];
#pragma unroll
    for (int a = 0; a < 2; ++a)
#pragma unroll
        for (int b = 0; b < 2; ++b)
#pragma unroll
            for (int m = 0; m < 4; ++m)
#pragma unroll
                for (int n = 0; n < 2; ++n) acc[a][b][m][n] = (f32x4){0.f, 0.f, 0.f, 0.f};
    bf16x8 At[4][2], B0[2][2], B1[2][2];
    const char* cA = (const char*)g.A + (size_t)cur.pm * tstep; const char* cB = (const char*)g.Bt + (size_t)cur.pn * tstep;
    S.a_ready(cur);
    if constexpr (SP2) {
        PG8_STAGE(PG8_SB(0, 0), cB, voffB); PG8_STAGE(PG8_SB(0, 1), cB + hstep, voffB); PG8_STAGE(PG8_SA(0, 0), cA, voffA); PG8_STAGE(PG8_SA(0, 1), cA + hstep, voffA);
        if (wr == 1) PG8_BAR;
        PG8_WAIT_V(2); PG8_BAR;
        PG8_STAGE(PG8_SB(1, 0), cB + kstep, voffB); PG8_STAGE(PG8_SA(1, 0), cA + kstep, voffA); PG8_STAGE(PG8_SB(1, 1), cB + hstep + kstep, voffB);
        PG8_WAIT_V(6); PG8_BAR;
    } else {
        PG8_STAGE(PG8_SB(0, 0), cB, voffB); PG8_STAGE(PG8_SA(0, 0), cA, voffA); PG8_STAGE(PG8_SB(0, 1), cB + hstep, voffB); PG8_STAGE(PG8_SA(0, 1), cA + hstep, voffA);
        if (wr == 1) PG8_BAR;
        PG8_WAIT_V(4); PG8_BAR;
        PG8_STAGE(PG8_SB(1, 0), cB + kstep, voffB); PG8_STAGE(PG8_SA(1, 0), cA + kstep, voffA); PG8_STAGE(PG8_SB(1, 1), cB + hstep + kstep, voffB);
        PG8_WAIT_V(6); PG8_BAR;
    }
    for (;;) {
        const bool has_next = S.next(ui + 1, nxt);
        const char* nA = has_next ? (const char*)g.A + (size_t)nxt.pm * tstep : cA; const char* nB = has_next ? (const char*)g.Bt + (size_t)nxt.pn * tstep : cB;
        for (int t = 0; t < nt; t += 2) {
            const bool last = (t == nt - 2);
            const char* a1 = cA + (size_t)(t + 1) * kstep;
            const char* a2 = last ? nA : cA + (size_t)(t + 2) * kstep; const char* b2 = last ? nB : cB + (size_t)(t + 2) * kstep;
            const char* a3 = a2 + kstep; const char* b3 = b2 + kstep;
            if (last && has_next) S.a_ready(nxt);
            if constexpr (SP2) {
            PG8_LDB(B0, 0, 0); PG8_LDB(B1, 0, 1); PG8_SCHED; PG8_LDA(At, 0, 0); PG8_STAGE(PG8_SA(1, 1), a1 + hstep, voffA);
            PG8_WAIT_V(8); PG8_WAIT_L(0); PG8_BAR; PG8_MMA(0, 0, At, B0); PG8_MMA(0, 1, At, B1); PG8_BAR; PG8_SCHED;
            PG8_LDA(At, 0, 1); PG8_STAGE(PG8_SB(0, 0), b2, voffB); PG8_STAGE(PG8_SB(0, 1), b2 + hstep, voffB); PG8_STAGE(PG8_SA(0, 0), a2, voffA);
            PG8_WAIT_V(8); PG8_WAIT_L(0); PG8_BAR; PG8_MMA(1, 0, At, B0); PG8_MMA(1, 1, At, B1); PG8_BAR; PG8_SCHED;
            PG8_LDB(B0, 1, 0); PG8_LDB(B1, 1, 1); PG8_SCHED; PG8_LDA(At, 1, 0); PG8_STAGE(PG8_SA(0, 1), a2 + hstep, voffA);
            PG8_WAIT_V(8); PG8_WAIT_L(0); PG8_BAR; PG8_MMA(0, 0, At, B0); PG8_MMA(0, 1, At, B1); PG8_BAR; PG8_SCHED;
            PG8_LDA(At, 1, 1); PG8_STAGE(PG8_SB(1, 0), b3, voffB); PG8_STAGE(PG8_SB(1, 1), b3 + hstep, voffB); PG8_STAGE(PG8_SA(1, 0), a3, voffA);
            PG8_WAIT_V(8); PG8_WAIT_L(0); PG8_BAR; PG8_MMA(1, 0, At, B0); PG8_MMA(1, 1, At, B1); PG8_BAR; PG8_SCHED;
            } else {
            PG8_LDB(B0, 0, 0); PG8_SCHED; PG8_LDA(At, 0, 0); PG8_STAGE(PG8_SA(1, 1), a1 + hstep, voffA);
            PG8_WAIT_L(8); PG8_BAR; PG8_WAIT_L(0); PG8_MMA(0, 0, At, B0); PG8_BAR; PG8_SCHED;
            PG8_LDB(B1, 0, 1); PG8_STAGE(PG8_SB(0, 0), b2, voffB);
            PG8_BAR; PG8_WAIT_L(0); PG8_MMA(0, 1, At, B1); PG8_BAR;
            PG8_LDA(At, 0, 1); PG8_STAGE(PG8_SA(0, 0), a2, voffA);
            PG8_BAR; PG8_WAIT_L(0); PG8_MMA(1, 0, At, B0); PG8_BAR; PG8_SCHED;
            PG8_STAGE(PG8_SB(0, 1), b2 + hstep, voffB);
            PG8_WAIT_V(6); PG8_BAR; PG8_MMA(1, 1, At, B1); PG8_BAR;
            PG8_LDB(B0, 1, 0); PG8_SCHED; PG8_LDA(At, 1, 0); PG8_STAGE(PG8_SA(0, 1), a2 + hstep, voffA);
            PG8_WAIT_L(8); PG8_BAR; PG8_WAIT_L(0); PG8_MMA(0, 0, At, B0); PG8_BAR; PG8_SCHED;
            PG8_LDB(B1, 1, 1); PG8_STAGE(PG8_SB(1, 0), b3, voffB);
            PG8_BAR; PG8_WAIT_L(0); PG8_MMA(0, 1, At, B1); PG8_BAR;
            PG8_LDA(At, 1, 1); PG8_STAGE(PG8_SA(1, 0), a3, voffA);
            PG8_BAR; PG8_WAIT_L(0); PG8_MMA(1, 0, At, B0); PG8_BAR; PG8_SCHED;
            PG8_STAGE(PG8_SB(1, 1), b3 + hstep, voffB);
            PG8_WAIT_V(6); PG8_BAR; PG8_MMA(1, 1, At, B1); PG8_BAR;
            }
        }
        if constexpr (ALIGN_EPI) { if (wr == 0) PG8_BAR; }
        if constexpr (!Epi::AFTER_DRAIN) { E(acc, cur, wr, wc, fr, fq); S.done(cur); }
        if (!has_next) break;
#pragma unroll
        for (int a = 0; a < 2; ++a)
#pragma unroll
            for (int b = 0; b < 2; ++b)
#pragma unroll
                for (int m = 0; m < 4; ++m)
#pragma unroll
                    for (int n = 0; n < 2; ++n) acc[a][b][m][n] = (f32x4){0.f, 0.f, 0.f, 0.f};
        cur = nxt; cA = nA; cB = nB; ++ui;
        if constexpr (ALIGN_EPI) { if (wr == 1) PG8_BAR; }
    }
    PG8_WAIT_V(0);
    if constexpr (!ALIGN_EPI) { if (wr == 0) PG8_BAR; }
    PG8_BAR;
    if constexpr (Epi::AFTER_DRAIN) { E.fused(acc, cur, wr, wc, fr, fq, lds, wid, lane); S.done(cur); }
#undef PG8_SA
#undef PG8_SB
#undef PG8_STAGE
#undef PG8_LDA
#undef PG8_LDB
#undef PG8_MMA
#undef PG8_WAIT_V
#undef PG8_WAIT_L
#undef PG8_BAR
#undef PG8_SCHED
}
}
#ifndef PG8_SP2
#define PG8_SP2 true
#endif
#ifndef PG8_ALIGN
#define PG8_ALIGN true
#endif
constexpr int NWAVES = 8;
#ifndef MK_N_LAUNCHES
#define MK_N_LAUNCHES 7
#endif
constexpr int N_LAUNCHES = MK_N_LAUNCHES;
constexpr int PER_PHASE = 7;

constexpr int BATCH = 16, SEQ = 2048, D = 1024, M = BATCH * SEQ;
constexpr int HW = 512;
constexpr int NHEAD = 8, HD = 64;
constexpr int PEER_H = 8, PEER_DK = 256, DHALF = 128, NKEYS = 128, NEXP = NKEYS * NKEYS, TOPK = 16, NSEL = PEER_H * TOPK;
constexpr float EPS = 1e-6f;
constexpr float QSCALE = 0.125f * 1.4426950408889634f;
constexpr float SB_EXIT = 152.0f;

constexpr size_t MiB = 1u << 20;
constexpr size_t WS_CTL = 0, CTL_ZERO_BYTES = 2 * MiB;
constexpr size_t WS_SSQ1 = 1 * MiB;
constexpr size_t WS_WIN = 2 * MiB, WS_WOUT = 8 * MiB, WS_WQ = 10 * MiB, WS_KEYS = 14 * MiB;
constexpr size_t WS_UT = 16 * MiB, WS_VTAB = 48 * MiB;
constexpr size_t WS_XN = 80 * MiB;
constexpr size_t WS_Q = 144 * MiB;
constexpr size_t WS_VTR = 304 * MiB;
constexpr size_t WS_QP = 144 * MiB;
constexpr size_t WS_MIX = 336 * MiB;
constexpr size_t WS_IDX = 400 * MiB, WS_GW = 416 * MiB, WS_END = 432 * MiB;
constexpr int CW_TMO = 0, CW_CODE = 1;
constexpr int CW_BAR = 4096;

constexpr int RING_OFF = 0, RING_BYTES = 131072;
constexpr int LDSCTL_OFF = RING_BYTES, MISC_OFF = LDSCTL_OFF + 320;
constexpr int LDS_BYTES = 147456;
static_assert(MISC_OFF + 128 <= LDS_BYTES, "LDS map");
#define GAS __attribute__((address_space(1)))
#define LAS __attribute__((address_space(3)))
typedef unsigned short bf16;
typedef unsigned v4u __attribute__((ext_vector_type(4)));
typedef float f32x4 __attribute__((ext_vector_type(4)));
typedef short bf16x8 __attribute__((ext_vector_type(8)));
typedef GAS unsigned gu32;
typedef GAS unsigned long long gu64;
#define RLX_AGENT __ATOMIC_RELAXED, __HIP_MEMORY_SCOPE_AGENT
#define LDS_WAIT() asm volatile("s_waitcnt lgkmcnt(0)" ::: "memory")
#define VM_WAIT() asm volatile("s_waitcnt vmcnt(0)" ::: "memory")
__device__ __forceinline__ unsigned long long rt() { return __builtin_amdgcn_s_memrealtime(); }
__device__ __forceinline__ unsigned f2bf(float f) { unsigned u = __builtin_bit_cast(unsigned, f); return (u + 0x7fffu + ((u >> 16) & 1u)) >> 16; }
__device__ __forceinline__ unsigned pk2(float lo, float hi) { return f2bf(lo) | (f2bf(hi) << 16); }
#define XB_TMO      128
#define XB_XCNT(j)  (256  + 64 * (j))
#define XB_XSUB(j)  (1280 + 64 * (j))
#define XB_XGEN(j)  (2304 + 64 * (j))
#define XB_TOP      3328
#define XB_TOPGEN   3392
#define XCD_BAR_WORDS 3456
#define XB_SPIN_CAP (1u << 18)

__device__ __forceinline__ unsigned xb_ld(unsigned* p)              { return __hip_atomic_load(p, __ATOMIC_RELAXED, __HIP_MEMORY_SCOPE_AGENT); }
__device__ __forceinline__ unsigned xb_add(unsigned* p, unsigned v) { return __hip_atomic_fetch_add(p, v, __ATOMIC_RELAXED, __HIP_MEMORY_SCOPE_AGENT); }
__device__ __forceinline__ unsigned xb_xcc_id() { return (unsigned)__builtin_amdgcn_s_getreg((3 << 11) | 20) & 0xFu; }
#define XB_SPIN(cond, bar) do { unsigned _sp = 0; while (cond) { __builtin_amdgcn_s_sleep(1); \
    if ((++_sp & 255u) == 0u) { if (xb_ld(&(bar)[XB_TMO])) break; if (_sp > XB_SPIN_CAP) { atomicAdd(&(bar)[XB_TMO], 1u); break; } } } } while (0)

struct XcdBarrier {
    unsigned* bar; unsigned x;
    volatile LAS unsigned* st;
};

__device__ __forceinline__ XcdBarrier xcd_barrier_post(unsigned* bar, volatile LAS unsigned* st) {
    XcdBarrier b; b.bar = bar; b.x = xb_xcc_id(); b.st = st;
    if (threadIdx.x == 0) (void)xb_add(&bar[XB_XCNT(b.x)], 1u);
    return b;
}
__device__ __forceinline__ void xcd_barrier_complete(unsigned* bar, unsigned x, unsigned& nloc, unsigned& nx) {
    const unsigned G = gridDim.x * gridDim.y * gridDim.z;
    unsigned sum, cnt, mine, sp = 0u;
    for (;;) {
        sum = 0u; cnt = 0u; mine = 0u;
#pragma unroll
        for (unsigned j = 0; j < 16; ++j) { const unsigned c = xb_ld(&bar[XB_XCNT(j)]); sum += c; cnt += (c > 0u) ? 1u : 0u; mine = (j == x) ? c : mine; }
        if (sum == G) break;
        __builtin_amdgcn_s_sleep(1);
        if ((++sp & 255u) == 0u) { if (xb_ld(&bar[XB_TMO])) break; if (sp > XB_SPIN_CAP) { atomicAdd(&bar[XB_TMO], 1u); break; } }
    }
    nloc = mine > 0u ? mine : 1u; nx = cnt > 0u ? cnt : 1u;
}

__device__ __forceinline__ void xcd_barrier(const XcdBarrier& b) {
    asm volatile("s_waitcnt vmcnt(0)" ::: "memory");
    __syncthreads();
    if (threadIdx.x == 0) {
        unsigned* bar = b.bar;
        __builtin_amdgcn_s_waitcnt(0);
        unsigned nloc = b.st[0], nx = b.st[1];
        if (nloc == 0u) { xcd_barrier_complete(bar, b.x, nloc, nx); b.st[0] = nloc; b.st[1] = nx; }
        const unsigned old = xb_add(&bar[XB_XSUB(b.x)], 1u);
        const unsigned gen = old / nloc;
        if (old + 1u == (gen + 1u) * nloc) {
            __builtin_amdgcn_fence(__ATOMIC_RELEASE, "agent");
            asm volatile("s_waitcnt vmcnt(0)" ::: "memory");
            const unsigned og = xb_add(&bar[XB_TOP], 1u);
            const unsigned tg = og / nx;
            if (og + 1u == (tg + 1u) * nx) xb_add(&bar[XB_TOPGEN], 1u);
            else XB_SPIN(xb_ld(&bar[XB_TOPGEN]) == tg, bar);
            __builtin_amdgcn_fence(__ATOMIC_ACQUIRE, "agent");
            xb_add(&bar[XB_XGEN(b.x)], 1u);
            asm volatile("s_waitcnt vmcnt(0)" ::: "memory");
        } else {
            XB_SPIN(xb_ld(&bar[XB_XGEN(b.x)]) == gen, bar);
            __builtin_amdgcn_fence(__ATOMIC_ACQUIRE, "agent");
            asm volatile("s_waitcnt vmcnt(0)" ::: "memory");
        }
    }
    __syncthreads();
}

typedef float f32x16 __attribute__((ext_vector_type(16)));
typedef short s16x4 __attribute__((ext_vector_type(4)));
typedef unsigned v2u __attribute__((ext_vector_type(2)));
struct Frame {
    LAS unsigned char* lds;
    volatile LAS unsigned* MISC;
    gu32* ctl;
    int tid, lane, wave;
    int vcu, G;
    const float *x, *mix_g, *w_in, *conv_w, *conv_b, *attn_g, *conv_g, *w_out, *ffn_g, *wq, *keys, *pu, *pv, *fin_g;
    float* out;
    bf16 *WinT, *WoutT, *WqT, *KEYSB, *UT, *VTAB, *XN, *Q, *K, *GB, *GC, *HC, *VTR, *QP, *MIX;
    float* SSQ1; int* IDX; float* GW;
};

__device__ __forceinline__ float wave_sum(float v) {
#pragma unroll
    for (int o = 1; o < 64; o <<= 1) v += __shfl_xor(v, o);
    return v;
}
__device__ __forceinline__ float bf_lo(unsigned w) { return __uint_as_float(w << 16); }
__device__ __forceinline__ float bf_hi(unsigned w) { return __uint_as_float(w & 0xffff0000u); }
typedef float f32x2_t __attribute__((ext_vector_type(2))); typedef __bf16 bf16x2_t __attribute__((ext_vector_type(2)));
__device__ __forceinline__ unsigned cvtpk(float lo, float hi) { f32x2_t v = {lo, hi}; bf16x2_t b = __builtin_convertvector(v, bf16x2_t); return __builtin_bit_cast(unsigned, b); }

__device__ __forceinline__ void p0_transpose_item(const float* W, int ldw, int K, int ncols, bf16* WT, int row_off, LAS float* scr, int item, int lane) {
    const int nblk = ncols / 32, kb = item / nblk, nb = item % nblk, k0 = 64 * kb, n0 = 32 * nb;
#pragma unroll 8
    for (int i = 0; i < 32; ++i) { const int kk = 2 * i + (lane >> 5); scr[kk * 33 + (lane & 31)] = W[(size_t)(k0 + kk) * ldw + n0 + (lane & 31)]; }
    LDS_WAIT(); asm volatile("" ::: "memory");
    const int c = lane & 7;
#pragma unroll
    for (int j = 0; j < 4; ++j) { const int n = (lane >> 3) + 8 * j; const LAS float* s = scr + (8 * c) * 33 + n;
        v4u o; o.x = pk2(s[0 * 33], s[1 * 33]); o.y = pk2(s[2 * 33], s[3 * 33]); o.z = pk2(s[4 * 33], s[5 * 33]); o.w = pk2(s[6 * 33], s[7 * 33]);
        *(GAS v4u*)(WT + (size_t)(row_off + n0 + n) * K + k0 + 8 * c) = o; }
    LDS_WAIT(); asm volatile("" ::: "memory");
}
__device__ __forceinline__ void p0_convert(const float* src, bf16* dst, size_t n8, size_t gt, size_t NGT) {
    for (size_t i = gt; i < n8; i += NGT) {
        const f32x4 a = ((const GAS f32x4*)src)[2 * i], b = ((const GAS f32x4*)src)[2 * i + 1];
        v4u o; o.x = pk2(a.x, a.y); o.y = pk2(a.z, a.w); o.z = pk2(b.x, b.y); o.w = pk2(b.z, b.w);
        ((GAS v4u*)dst)[i] = o; }
}
__device__ __forceinline__ void rms_row_to_bf16(Frame& F, const float* xrow, const float* g, bf16* orow) {
    const GAS f32x4* xr = (const GAS f32x4*)xrow + F.lane; const GAS f32x4* gr = (const GAS f32x4*)g + F.lane;
    f32x4 v[4]; float s = 0.f;
#pragma unroll
    for (int j = 0; j < 4; ++j) { v[j] = xr[64 * j]; s += (v[j].x * v[j].x + v[j].y * v[j].y) + (v[j].z * v[j].z + v[j].w * v[j].w); }
    const float rinv = rsqrtf(wave_sum(s) * (1.f / D) + EPS);
    GAS unsigned long long* o8 = (GAS unsigned long long*)orow + F.lane;
#pragma unroll
    for (int j = 0; j < 4; ++j) { const f32x4 gg = gr[64 * j];
        o8[64 * j] = (unsigned long long)pk2(v[j].x * rinv * gg.x, v[j].y * rinv * gg.y) | ((unsigned long long)pk2(v[j].z * rinv * gg.z, v[j].w * rinv * gg.w) << 32); }
}
__device__ __forceinline__ void p0_prologue(Frame& F) {
    LAS float* scr = (LAS float*)(F.lds + RING_OFF + F.wave * 16384);
    const int gw = F.vcu * NWAVES + F.wave, NGW = F.G * NWAVES;
    constexpr int I0 = (D / 64) * (1024 / 32), I1 = (D / 64) * (512 / 32), I2 = (D / 64) * (1536 / 32), I3 = (D / 64) * (D / 32), I4 = (D / 64) * (2048 / 32);
    constexpr int NITEMS = I0 + I1 + I2 + I3 + I4;
    for (int it = gw; it < NITEMS; it += NGW) {
        int r = it;
        if (r < I0) { p0_transpose_item(F.w_in, 3072, D, 1024, F.WinT, 0, scr, r, F.lane); continue; } r -= I0;
        if (r < I1) { p0_transpose_item(F.w_in + 1024, 3072, D, 512, F.WinT, 2560, scr, r, F.lane); continue; } r -= I1;
        if (r < I2) { p0_transpose_item(F.w_in + 1536, 3072, D, 1536, F.WinT, 1024, scr, r, F.lane); continue; } r -= I2;
        if (r < I3) { p0_transpose_item(F.w_out, D, D, D, F.WoutT, 0, scr, r, F.lane); continue; } r -= I3;
        p0_transpose_item(F.wq, 2048, D, 2048, F.WqT, 0, scr, r, F.lane);
    }
    const size_t gt = (size_t)F.vcu * (NWAVES * 64) + F.tid, NGT = (size_t)F.G * (NWAVES * 64);
    p0_convert(F.keys, F.KEYSB, (size_t)2 * PEER_H * NKEYS * DHALF / 8, gt, NGT);
    p0_convert(F.pu, F.UT, (size_t)NEXP * D / 8, gt, NGT);
    p0_convert(F.pv, F.VTAB, (size_t)NEXP * D / 8, gt, NGT);
    for (int m = gw; m < M; m += NGW) rms_row_to_bf16(F, F.x + (size_t)m * D, F.mix_g, F.XN + (size_t)m * D);
}

__device__ __forceinline__ int crow(int r, int hi) { return (r & 3) + 8 * (r >> 2) + 4 * hi; }
__device__ __forceinline__ void attn_phase(Frame& F) {
    const int lane = F.lane, q32 = lane & 31, hi = lane >> 5, h = F.wave;
    LAS float* ssq_lds = (LAS float*)(F.lds + RING_OFF);
    constexpr int NUNIT = BATCH * (SEQ / 32);
    int par = 0;
    for (int unit = F.vcu; unit < NUNIT; unit += F.G, par ^= 1) {
        const int b = unit >> 6, qb = unit & 63;
        const size_t brow = (size_t)b * SEQ; const int t0 = qb * 32;
        bf16x8 qf[4];
        { const bf16* Qp = F.Q + (brow + t0 + q32) * HW + h * HD + hi * 8;
#pragma unroll
          for (int ks = 0; ks < 4; ++ks) qf[ks] = *(const bf16x8*)(Qp + ks * 16); }
        f32x16 o0 = {}, o1 = {}; float c = 0.f;
        for (int kt = qb; kt >= 0; --kt) {
            const int key0 = kt * 32;
            bf16x8 kf[4];
            { const bf16* Kp = F.K + (brow + key0 + q32) * HW + h * HD + hi * 8;
#pragma unroll
              for (int ks = 0; ks < 4; ++ks) kf[ks] = *(const bf16x8*)(Kp + ks * 16); }
            s16x4 va[2][2], vb[2][2];
            { const bf16* Vp = F.VTR + (size_t)(h * HD + q32) * M + brow + key0 + 4 * hi;
#pragma unroll
              for (int db = 0; db < 2; ++db)
#pragma unroll
                for (int s = 0; s < 2; ++s) { va[db][s] = *(const s16x4*)(Vp + (size_t)db * 32 * M + s * 16); vb[db][s] = *(const s16x4*)(Vp + (size_t)db * 32 * M + s * 16 + 8); } }
            f32x16 S = {};
#pragma unroll
            for (int ks = 0; ks < 4; ++ks) S = __builtin_amdgcn_mfma_f32_32x32x16_bf16(kf[ks], qf[ks], S, 0, 0, 0);
            const bool diag = (kt == qb);
            float lm[16], zz[16];
#pragma unroll
            for (int r = 0; r < 16; ++r) {
                const float z = S[r];
                const float e = __builtin_amdgcn_exp2f(-__builtin_fabsf(z));
                const float sp = __builtin_fmaxf(z, 0.f) + __builtin_amdgcn_logf(1.0f + e);
                const bool valid = !diag || (crow(r, hi) < q32);
                lm[r] = valid ? -sp : 0.f; zz[r] = z - sp;
            }
            float suf[16], T[4];
#pragma unroll
            for (int g = 0; g < 4; ++g) { suf[4 * g + 3] = 0.f; suf[4 * g + 2] = lm[4 * g + 3]; suf[4 * g + 1] = suf[4 * g + 2] + lm[4 * g + 2]; suf[4 * g] = suf[4 * g + 1] + lm[4 * g + 1]; T[g] = suf[4 * g] + lm[4 * g]; }
            float Lh[4], Hh[4];
#pragma unroll
            for (int g = 0; g < 4; ++g) { auto rr = __builtin_amdgcn_permlane32_swap(__float_as_uint(T[g]), __float_as_uint(T[g]), false, false); Lh[g] = __uint_as_float(rr[0]); Hh[g] = __uint_as_float(rr[1]); }
            float A[4]; A[3] = 0.f;
#pragma unroll
            for (int g = 2; g >= 0; --g) A[g] = A[g + 1] + (Lh[g + 1] + Hh[g + 1]);
            const float total = A[0] + (Lh[0] + Hh[0]);
            float a[16];
#pragma unroll
            for (int r = 0; r < 16; ++r) {
                const int g = r >> 2;
                const float E = A[g] + (hi ? 0.f : Hh[g]);
                const float arg = zz[r] + suf[r] + E + c;
                const bool valid = !diag || (crow(r, hi) < q32);
                a[r] = valid ? __builtin_amdgcn_exp2f(arg) : 0.f;
            }
            c += total;
#pragma unroll
            for (int s = 0; s < 2; ++s) {
                v4u pw; pw.x = cvtpk(a[8 * s], a[8 * s + 1]); pw.y = cvtpk(a[8 * s + 2], a[8 * s + 3]); pw.z = cvtpk(a[8 * s + 4], a[8 * s + 5]); pw.w = cvtpk(a[8 * s + 6], a[8 * s + 7]);
                const bf16x8 pb = __builtin_bit_cast(bf16x8, pw);
                const bf16x8 v0 = (bf16x8){va[0][s][0], va[0][s][1], va[0][s][2], va[0][s][3], vb[0][s][0], vb[0][s][1], vb[0][s][2], vb[0][s][3]};
                const bf16x8 v1 = (bf16x8){va[1][s][0], va[1][s][1], va[1][s][2], va[1][s][3], vb[1][s][0], vb[1][s][1], vb[1][s][2], vb[1][s][3]};
                o0 = __builtin_amdgcn_mfma_f32_32x32x16_bf16(v0, pb, o0, 0, 0, 0);
                o1 = __builtin_amdgcn_mfma_f32_32x32x16_bf16(v1, pb, o1, 0, 0, 0);
            }
            if (__all(c < -SB_EXIT)) break;
        }
        float sq = 0.f;
#pragma unroll
        for (int r = 0; r < 16; ++r) sq += o0[r] * o0[r] + o1[r] * o1[r];
        { auto rr = __builtin_amdgcn_permlane32_swap(__float_as_uint(sq), __float_as_uint(sq), false, false); sq = __uint_as_float(rr[0]) + __uint_as_float(rr[1]); }
        if (hi == 0) ssq_lds[(par * 8 + h) * 32 + q32] = sq;
        __syncthreads();
        float tot = 0.f;
#pragma unroll
        for (int w = 0; w < 8; ++w) tot += ssq_lds[(par * 8 + w) * 32 + q32];
        const float rinv = rsqrtf(tot * (1.f / HW) + EPS);
        bf16* Op = F.MIX + (brow + t0 + q32) * D + h * HD + 4 * hi;
        const float* gp = F.attn_g + h * HD + 4 * hi;
#pragma unroll
        for (int db = 0; db < 2; ++db)
#pragma unroll
            for (int g = 0; g < 4; ++g) {
                const f32x4 gg = *(const f32x4*)(gp + db * 32 + 8 * g);
                const f32x16& o = db ? o1 : o0;
                v2u w; w.x = cvtpk(o[4 * g] * rinv * gg.x, o[4 * g + 1] * rinv * gg.y); w.y = cvtpk(o[4 * g + 2] * rinv * gg.z, o[4 * g + 3] * rinv * gg.w);
                *(v2u*)(Op + db * 32 + 8 * g) = w;
            }
    }
}
__device__ __forceinline__ void conv_phase(Frame& F) {
    const int gw = F.vcu * NWAVES + F.wave, NGW = F.G * NWAVES, c8 = F.lane * 8;
    float w0[8], w1[8], w2[8], bb[8], gg[8];
#pragma unroll
    for (int i = 0; i < 8; ++i) { w0[i] = F.conv_w[c8 + i]; w1[i] = F.conv_w[HW + c8 + i]; w2[i] = F.conv_w[2 * HW + c8 + i]; bb[i] = F.conv_b[c8 + i]; gg[i] = F.conv_g[c8 + i]; }
    for (int row = gw; row < M; row += NGW) {
        const int t = row & (SEQ - 1);
        const size_t off = (size_t)row * HW + c8;
        const v4u gbv = *(const v4u*)(F.GB + off);
        v4u gc0 = *(const v4u*)(F.GC + off), hc0 = *(const v4u*)(F.HC + off);
        v4u gc1 = {0, 0, 0, 0}, hc1 = {0, 0, 0, 0}, gc2 = {0, 0, 0, 0}, hc2 = {0, 0, 0, 0};
        if (t >= 1) { gc1 = *(const v4u*)(F.GC + off - HW); hc1 = *(const v4u*)(F.HC + off - HW); }
        if (t >= 2) { gc2 = *(const v4u*)(F.GC + off - 2 * HW); hc2 = *(const v4u*)(F.HC + off - 2 * HW); }
        float oc[8]; float s = 0.f;
#pragma unroll
        for (int i = 0; i < 4; ++i) {
            const float u0l = bf_lo(gc0[i]) * bf_lo(hc0[i]), u0h = bf_hi(gc0[i]) * bf_hi(hc0[i]);
            const float u1l = bf_lo(gc1[i]) * bf_lo(hc1[i]), u1h = bf_hi(gc1[i]) * bf_hi(hc1[i]);
            const float u2l = bf_lo(gc2[i]) * bf_lo(hc2[i]), u2h = bf_hi(gc2[i]) * bf_hi(hc2[i]);
            const float yl = w0[2 * i] * u2l + w1[2 * i] * u1l + w2[2 * i] * u0l + bb[2 * i];
            const float yh = w0[2 * i + 1] * u2h + w1[2 * i + 1] * u1h + w2[2 * i + 1] * u0h + bb[2 * i + 1];
            oc[2 * i] = bf_lo(gbv[i]) * yl; oc[2 * i + 1] = bf_hi(gbv[i]) * yh;
            s += oc[2 * i] * oc[2 * i] + oc[2 * i + 1] * oc[2 * i + 1];
        }
        const float rinv = rsqrtf(wave_sum(s) * (1.f / HW) + EPS);
        v4u o;
        o.x = cvtpk(oc[0] * rinv * gg[0], oc[1] * rinv * gg[1]); o.y = cvtpk(oc[2] * rinv * gg[2], oc[3] * rinv * gg[3]);
        o.z = cvtpk(oc[4] * rinv * gg[4], oc[5] * rinv * gg[5]); o.w = cvtpk(oc[6] * rinv * gg[6], oc[7] * rinv * gg[7]);
        *(v4u*)(F.MIX + (size_t)row * D + HW + c8) = o;
    }
}

__device__ __forceinline__ unsigned f2sortable(float f) { const unsigned u = __float_as_uint(f); return u ^ ((unsigned)((int)u >> 31) | 0x80000000u); }
__device__ __forceinline__ float sortable2f(unsigned s) { const unsigned u = (s & 0x80000000u) ? (s ^ 0x80000000u) : ~s; return __uint_as_float(u); }
__device__ __forceinline__ unsigned umax_(unsigned a, unsigned b) { return a > b ? a : b; }
__device__ __forceinline__ unsigned umin_(unsigned a, unsigned b) { return a < b ? a : b; }
__device__ __forceinline__ void sort16(unsigned (&a)[16]) {
#pragma unroll
    for (int k = 2; k <= 16; k <<= 1)
#pragma unroll
        for (int j = k >> 1; j > 0; j >>= 1)
#pragma unroll
            for (int i = 0; i < 16; ++i) { const int l = i ^ j;
                if (l > i) { const unsigned mx = umax_(a[i], a[l]), mn = umin_(a[i], a[l]); if ((i & k) == 0) { a[i] = mx; a[l] = mn; } else { a[i] = mn; a[l] = mx; } } }
}
__device__ __forceinline__ void merge16(unsigned (&a)[16], const unsigned (&b)[16]) {
#pragma unroll
    for (int i = 0; i < 16; ++i) a[i] = umax_(a[i], b[15 - i]);
#pragma unroll
    for (int j = 8; j > 0; j >>= 1)
#pragma unroll
        for (int i = 0; i < 16; ++i) { const int l = i ^ j; if (l > i) { const unsigned mx = umax_(a[i], a[l]), mn = umin_(a[i], a[l]); a[i] = mx; a[l] = mn; } }
}
__device__ __forceinline__ void merge_halves(unsigned (&a)[16]) {
    unsigned x[16], y[16];
#pragma unroll
    for (int i = 0; i < 16; ++i) { auto rr = __builtin_amdgcn_permlane32_swap(a[i], a[i], false, false); x[i] = rr[0]; y[i] = rr[1]; }
    merge16(x, y);
#pragma unroll
    for (int i = 0; i < 16; ++i) a[i] = x[i];
}
struct PairTab { int pi[64], pj[64], n; };
constexpr PairTab make_pairs() { PairTab t{}; int n = 0; for (int i = 0; i < 16; ++i) for (int j = 0; j < 16; ++j) if ((i + 1) * (j + 1) <= 16) { t.pi[n] = i; t.pj[n] = j; ++n; } t.n = n; for (int k = n; k < 64; ++k) { t.pi[k] = 0; t.pj[k] = 0; } return t; }
constexpr PairTab PAIRS = make_pairs();
static_assert(PAIRS.n == 50, "candidate pairs");
constexpr int KEY_PITCH = 272;
constexpr int LDS_KEYS = 0, LDS_LKP = 2 * NKEYS * KEY_PITCH;
__device__ __forceinline__ void score_half_top16(Frame& F, const bf16* qrow  , int half, int q32, int hi, unsigned (&top)[16]) {
    bf16x8 qf[8];
#pragma unroll
    for (int ks = 0; ks < 8; ++ks) qf[ks] = *(const bf16x8*)(qrow + ks * 16);
    unsigned cur[16];
#pragma unroll
    for (int tl = 0; tl < 4; ++tl) {
        f32x16 S = {};
        const LAS unsigned char* kp = F.lds + LDS_KEYS + (half * NKEYS + tl * 32 + q32) * KEY_PITCH + hi * 16;
#pragma unroll
        for (int ks = 0; ks < 8; ++ks) { const bf16x8 kf = *(const LAS bf16x8*)(kp + ks * 32); S = __builtin_amdgcn_mfma_f32_32x32x16_bf16(kf, qf[ks], S, 0, 0, 0); }
        unsigned a[16];
#pragma unroll
        for (int r = 0; r < 16; ++r) a[r] = (f2sortable(S[r]) & ~127u) | (unsigned)(tl * 32 + crow(r, hi));
        sort16(a);
        if (tl == 0) {
#pragma unroll
            for (int i = 0; i < 16; ++i) cur[i] = a[i];
        } else merge16(cur, a);
    }
    merge_halves(cur);
#pragma unroll
    for (int i = 0; i < 16; ++i) top[i] = cur[i];
}
__device__ __forceinline__ void topk_phase(Frame& F) {
    const int lane = F.lane, q32 = lane & 31, hi = lane >> 5;
    LAS unsigned* lkp = (LAS unsigned*)(F.lds + LDS_LKP + F.wave * 2048) + lane * 8;
    LAS unsigned char* lkpb = (LAS unsigned char*)lkp;
    constexpr int TOKB = 1024, NUNIT = (M / TOKB) * PEER_H;
    for (int unit = F.vcu; unit < NUNIT; unit += F.G) {
        const int h = unit & 7, sb = unit >> 3;
        __syncthreads();
        for (int ch = F.tid; ch < 2 * NKEYS * 16; ch += NWAVES * 64) {
            const int hf = ch >> 11, key = (ch >> 4) & 127, cc = ch & 15;
            const v4u v = *(const GAS v4u*)(F.KEYSB + ((size_t)(hf * PEER_H + h) * NKEYS + key) * DHALF + cc * 8);
            *(LAS v4u*)(F.lds + LDS_KEYS + (hf * NKEYS + key) * KEY_PITCH + cc * 16) = v;
        }
        __syncthreads();
        for (int blk = 0; blk < TOKB / 32 / NWAVES; ++blk) {
            const int tok = sb * TOKB + (blk * NWAVES + F.wave) * 32 + q32;
            const bf16* qrow = F.QP + (size_t)tok * (PEER_H * PEER_DK) + h * PEER_DK + hi * 8;
            unsigned t1[16], t2[16];
            score_half_top16(F, qrow, 0, q32, hi, t1);
            score_half_top16(F, qrow + DHALF, 1, q32, hi, t2);
#pragma unroll
            for (int i = 0; i < 4; ++i) {
                lkp[i] = (t1[4 * i] & 127u) | ((t1[4 * i + 1] & 127u) << 8) | ((t1[4 * i + 2] & 127u) << 16) | ((t1[4 * i + 3] & 127u) << 24);
                lkp[4 + i] = (t2[4 * i] & 127u) | ((t2[4 * i + 1] & 127u) << 8) | ((t2[4 * i + 2] & 127u) << 16) | ((t2[4 * i + 3] & 127u) << 24);
            }
            float v1[16], v2[16];
#pragma unroll
            for (int i = 0; i < 16; ++i) { v1[i] = sortable2f(t1[i] & ~127u); v2[i] = sortable2f(t2[i] & ~127u); }
            unsigned best[16];
#pragma unroll
            for (int g = 0; g < 4; ++g) {
                unsigned cnd[16];
#pragma unroll
                for (int e = 0; e < 16; ++e) { const int k = g * 16 + e;
                    if (k < PAIRS.n) cnd[e] = (f2sortable(v1[PAIRS.pi[k]] + v2[PAIRS.pj[k]]) & ~255u) | (unsigned)(PAIRS.pi[k] * 16 + PAIRS.pj[k]); else cnd[e] = 0u; }
                sort16(cnd);
                if (g == 0) {
#pragma unroll
                    for (int i = 0; i < 16; ++i) best[i] = cnd[i];
                } else merge16(best, cnd);
            }
            LDS_WAIT();
            float bv[16]; int ex[16];
#pragma unroll
            for (int k = 0; k < 16; ++k) { const unsigned code = best[k] & 255u; bv[k] = sortable2f(best[k] & ~255u);
                const int i1 = lkpb[code >> 4], i2 = lkpb[16 + (code & 15u)]; ex[k] = i1 * NKEYS + i2; }
            float ssum = 0.f; const float bmax = bv[0];
#pragma unroll
            for (int k = 0; k < 16; ++k) { bv[k] = __expf(bv[k] - bmax); ssum += bv[k]; }
            const float rs = 1.0f / ssum;
            const size_t o = ((size_t)tok * PEER_H + h) * TOPK;
            if (hi == 0) {
#pragma unroll
                for (int k4 = 0; k4 < 4; ++k4) { v4u w; w.x = (unsigned)ex[4 * k4]; w.y = (unsigned)ex[4 * k4 + 1]; w.z = (unsigned)ex[4 * k4 + 2]; w.w = (unsigned)ex[4 * k4 + 3]; *(GAS v4u*)(F.IDX + o + 4 * k4) = w; }
            } else {
#pragma unroll
                for (int k4 = 0; k4 < 4; ++k4) { f32x4 w; w.x = bv[4 * k4] * rs; w.y = bv[4 * k4 + 1] * rs; w.z = bv[4 * k4 + 2] * rs; w.w = bv[4 * k4 + 3] * rs; *(GAS f32x4*)(F.GW + o + 4 * k4) = w; }
            }
            LDS_WAIT();
        }
    }
}

__device__ __forceinline__ float gelu_tanh(float x) {
    const float y = 0.7978845608028654f * (x + 0.044715f * x * x * x);
    const float e = __expf(2.0f * y);
    const float th = 1.0f - 2.0f / (1.0f + e);
    return 0.5f * x * (1.0f + th);
}
__device__ __forceinline__ void peer_phase(Frame& F) {
    const int gw = F.vcu * NWAVES + F.wave, NGW = F.G * NWAVES, lane = F.lane;
    for (int tok = gw; tok < M; tok += NGW) {
        const float rinv1 = rsqrtf(F.SSQ1[tok] * (1.f / D) + EPS);
        float xn[16];
#pragma unroll
        for (int cch = 0; cch < 2; ++cch) { const v4u w = *(const GAS v4u*)(F.XN + (size_t)tok * D + cch * 512 + lane * 8);
#pragma unroll
            for (int i = 0; i < 4; ++i) { xn[cch * 8 + 2 * i] = bf_lo(w[i]) * rinv1; xn[cch * 8 + 2 * i + 1] = bf_hi(w[i]) * rinv1; } }
        const int idxA = F.IDX[(size_t)tok * NSEL + lane], idxB = F.IDX[(size_t)tok * NSEL + 64 + lane];
        const float gA = F.GW[(size_t)tok * NSEL + lane], gB = F.GW[(size_t)tok * NSEL + 64 + lane];
        float out[16];
#pragma unroll
        for (int i = 0; i < 16; ++i) out[i] = 0.f;
        for (int half = 0; half < 2; ++half) {
            const int idxv = half ? idxB : idxA; const float gv = half ? gB : gA;
            for (int k0 = 0; k0 < 64; k0 += 8) {
                v4u ur[8][2]; int e[8];
#pragma unroll
                for (int j = 0; j < 8; ++j) { e[j] = __builtin_amdgcn_readlane(idxv, k0 + j);
                    const bf16* up = F.UT + (size_t)e[j] * D + lane * 8; ur[j][0] = *(const GAS v4u*)up; ur[j][1] = *(const GAS v4u*)(up + 512); }
                float w[8];
#pragma unroll
                for (int j = 0; j < 8; ++j) { float p = 0.f;
#pragma unroll
                    for (int cch = 0; cch < 2; ++cch)
#pragma unroll
                        for (int i = 0; i < 4; ++i) { p += bf_lo(ur[j][cch][i]) * xn[cch * 8 + 2 * i]; p += bf_hi(ur[j][cch][i]) * xn[cch * 8 + 2 * i + 1]; }
                    p = wave_sum(p);
                    const float g = __uint_as_float(__builtin_amdgcn_readlane(__float_as_uint(gv), k0 + j));
                    w[j] = g * gelu_tanh(p); }
#pragma unroll
                for (int j = 0; j < 8; ++j) { const bf16* vp = F.VTAB + (size_t)e[j] * D + lane * 8; ur[j][0] = *(const GAS v4u*)vp; ur[j][1] = *(const GAS v4u*)(vp + 512); }
#pragma unroll
                for (int j = 0; j < 8; ++j)
#pragma unroll
                    for (int cch = 0; cch < 2; ++cch)
#pragma unroll
                        for (int i = 0; i < 4; ++i) { out[cch * 8 + 2 * i] += w[j] * bf_lo(ur[j][cch][i]); out[cch * 8 + 2 * i + 1] += w[j] * bf_hi(ur[j][cch][i]); }
            }
        }
        float x2[16]; float s = 0.f;
        const float* x1p = F.out + (size_t)tok * D + lane * 8;
#pragma unroll
        for (int cch = 0; cch < 2; ++cch) { const f32x4 a = *(const GAS f32x4*)(x1p + cch * 512), b = *(const GAS f32x4*)(x1p + cch * 512 + 4);
            x2[cch * 8 + 0] = a.x + out[cch * 8 + 0]; x2[cch * 8 + 1] = a.y + out[cch * 8 + 1]; x2[cch * 8 + 2] = a.z + out[cch * 8 + 2]; x2[cch * 8 + 3] = a.w + out[cch * 8 + 3];
            x2[cch * 8 + 4] = b.x + out[cch * 8 + 4]; x2[cch * 8 + 5] = b.y + out[cch * 8 + 5]; x2[cch * 8 + 6] = b.z + out[cch * 8 + 6]; x2[cch * 8 + 7] = b.w + out[cch * 8 + 7]; }
#pragma unroll
        for (int i = 0; i < 16; ++i) s += x2[i] * x2[i];
        const float rinv = rsqrtf(wave_sum(s) * (1.f / D) + EPS);
        float* op = F.out + (size_t)tok * D + lane * 8; const float* fg = F.fin_g + lane * 8;
#pragma unroll
        for (int cch = 0; cch < 2; ++cch) { const f32x4 g0 = *(const f32x4*)(fg + cch * 512), g1 = *(const f32x4*)(fg + cch * 512 + 4);
            f32x4 a, b; a.x = x2[cch * 8 + 0] * rinv * g0.x; a.y = x2[cch * 8 + 1] * rinv * g0.y; a.z = x2[cch * 8 + 2] * rinv * g0.z; a.w = x2[cch * 8 + 3] * rinv * g0.w;
            b.x = x2[cch * 8 + 4] * rinv * g1.x; b.y = x2[cch * 8 + 5] * rinv * g1.y; b.z = x2[cch * 8 + 6] * rinv * g1.z; b.w = x2[cch * 8 + 7] * rinv * g1.w;
            *(GAS f32x4*)(op + cch * 512) = a; *(GAS f32x4*)(op + cch * 512 + 4) = b; }
    }
}

struct Args { const float* in[14]; float* out; unsigned char* ws; int ph_lo, ph_hi, li, pad; };
__global__ void __launch_bounds__(NWAVES * 64, 2) mk_fwd(Args args) {
    extern __shared__ __attribute__((aligned(16))) unsigned char lds[];
    Frame F;
    F.lds = (LAS unsigned char*)lds;
    F.MISC = (volatile LAS unsigned*)(F.lds + MISC_OFF);
    F.tid = threadIdx.x; F.lane = F.tid & 63; F.wave = __builtin_amdgcn_readfirstlane(F.tid >> 6);
    F.G = gridDim.x; { const int bx = blockIdx.x; F.vcu = (F.G % 8 == 0) ? (bx % 8) * (F.G / 8) + bx / 8 : bx; }
#define GRID_BAR(seam) do { if (N_LAUNCHES == PER_PHASE) { if (F.tid == 0) __hip_atomic_store(F.ctl + CW_TMO, 0xBADBA0u | (unsigned)(seam), RLX_AGENT); } \
    else { xcd_barrier(bar); } } while (0)
    unsigned char* ws = args.ws;
    F.ctl = (gu32*)(ws + WS_CTL);
    F.x = args.in[0]; F.mix_g = args.in[1]; F.w_in = args.in[2]; F.conv_w = args.in[3]; F.conv_b = args.in[4]; F.attn_g = args.in[5]; F.conv_g = args.in[6];
    F.w_out = args.in[7]; F.ffn_g = args.in[8]; F.wq = args.in[9]; F.keys = args.in[10]; F.pu = args.in[11]; F.pv = args.in[12]; F.fin_g = args.in[13];
    F.out = args.out;
    F.WinT = (bf16*)(ws + WS_WIN); F.WoutT = (bf16*)(ws + WS_WOUT); F.WqT = (bf16*)(ws + WS_WQ); F.KEYSB = (bf16*)(ws + WS_KEYS);
    F.UT = (bf16*)(ws + WS_UT); F.VTAB = (bf16*)(ws + WS_VTAB); F.XN = (bf16*)(ws + WS_XN);
    F.Q = (bf16*)(ws + WS_Q); F.K = F.Q + (size_t)M * HW; F.GB = F.K + (size_t)M * HW; F.GC = F.GB + (size_t)M * HW; F.HC = F.GC + (size_t)M * HW;
    F.VTR = (bf16*)(ws + WS_VTR); F.QP = (bf16*)(ws + WS_QP); F.MIX = (bf16*)(ws + WS_MIX);
    F.SSQ1 = (float*)(ws + WS_SSQ1); F.IDX = (int*)(ws + WS_IDX); F.GW = (float*)(ws + WS_GW);
    for (int u = F.tid; u < (LDS_BYTES - LDSCTL_OFF) / 4; u += NWAVES * 64) ((LAS unsigned*)(F.lds + LDSCTL_OFF))[u] = 0u;
    __syncthreads();
    XcdBarrier bar; bar.bar = (unsigned*)(F.ctl + CW_BAR); bar.x = 0; bar.st = nullptr;
    if (N_LAUNCHES != PER_PHASE) bar = xcd_barrier_post((unsigned*)(F.ctl + CW_BAR), F.MISC + 8);
    const int lo = args.ph_lo, hi = args.ph_hi;
#define IN(k) (lo <= (k) && (k) < hi)
#define BOTH(k) (IN(k) && IN((k) + 1))

    if (IN(0)) { p0_prologue(F); if (BOTH(0)) GRID_BAR(0); }

    if (IN(1)) {
        { pg8::Gemm g{F.XN, F.WinT, M, 5 * HW, D}; pg8::StaticOrder S; S.init(M, 5 * HW, F.G, (int)blockIdx.x);
          pg8::EpiBf16<0> E{F.Q, HW, nullptr, HW, (size_t)M * HW, QSCALE};
          pg8::gemm_phase<pg8::EpiBf16<0>, pg8::StaticOrder, PG8_ALIGN, PG8_SP2>(F.lds + RING_OFF, g, S, E); }
        { pg8::Gemm g{F.WinT + (size_t)5 * HW * D, F.XN, HW, M, D}; pg8::StaticOrder S; S.init(HW, M, F.G, (int)blockIdx.x);
          pg8::EpiBf16<0> E{F.VTR, M, nullptr, 0, 0, 1.f};
          pg8::gemm_phase<pg8::EpiBf16<0>, pg8::StaticOrder, PG8_ALIGN, PG8_SP2>(F.lds + RING_OFF, g, S, E); }
        if (BOTH(1)) GRID_BAR(1);
    }

    if (IN(2)) { attn_phase(F); conv_phase(F); if (BOTH(2)) GRID_BAR(2); }

    if (IN(3)) {
        pg8::Gemm g{F.MIX, F.WoutT, M, D, D}; pg8::StaticOrder S; S.init(M, D, F.G, (int)blockIdx.x);
        pg8::EpiResid E{F.x, F.out, F.XN, F.ffn_g, F.SSQ1, D};
        pg8::gemm_phase<pg8::EpiResid, pg8::StaticOrder, PG8_ALIGN, PG8_SP2>(F.lds + RING_OFF, g, S, E);
        if (BOTH(3)) GRID_BAR(3);
    }

    if (IN(4)) {
        pg8::Gemm g{F.XN, F.WqT, M, PEER_H * PEER_DK, D}; pg8::StaticOrder S; S.init(M, PEER_H * PEER_DK, F.G, (int)blockIdx.x);
        pg8::EpiBf16Rs E{F.QP, PEER_H * PEER_DK, F.SSQ1, 1.f / D, EPS};
        pg8::gemm_phase<pg8::EpiBf16Rs, pg8::StaticOrder, PG8_ALIGN, PG8_SP2>(F.lds + RING_OFF, g, S, E);
        if (BOTH(4)) GRID_BAR(4);
    }

    if (IN(5)) { topk_phase(F); if (BOTH(5)) GRID_BAR(5); }

    if (IN(6)) { peer_phase(F); }
#undef IN
#undef BOTH
}

extern "C" void kernel_launch(void* const* d_in, const int* in_sizes, int n_in, void* d_out, int out_size, void* d_ws, size_t ws_size, hipStream_t stream) {
    static int grid = 0;
    if (grid == 0) {
        if (n_in != 14 || in_sizes[0] != M * D || out_size != M * D || ws_size < WS_END) { fprintf(stderr, "kernel_launch: unexpected shapes: n_in %d in0 %d out %d ws %zu\n", n_in, n_in > 0 ? in_sizes[0] : -1, out_size, ws_size); grid = -1; return; }
        int dev = 0, cus = 0, per_cu = 0;
        if (hipGetDevice(&dev) != hipSuccess || hipDeviceGetAttribute(&cus, hipDeviceAttributeMultiprocessorCount, dev) != hipSuccess) { grid = -1; return; }
        if (hipFuncSetAttribute((const void*)mk_fwd, hipFuncAttributeMaxDynamicSharedMemorySize, LDS_BYTES) != hipSuccess) { fprintf(stderr, "kernel_launch: hipFuncSetAttribute failed\n"); grid = -1; return; }
        if (hipOccupancyMaxActiveBlocksPerMultiprocessor(&per_cu, (const void*)mk_fwd, NWAVES * 64, LDS_BYTES) != hipSuccess || per_cu < 1)
            fprintf(stderr, "kernel_launch: note: occupancy query reports %d workgroups per CU\n", per_cu);
        (void)hipGetLastError();
        grid = cus;
    }
    if (grid < 0) return;
    if (hipMemsetAsync((char*)d_ws + WS_CTL, 0, CTL_ZERO_BYTES, stream) != hipSuccess) { fprintf(stderr, "kernel_launch: hipMemsetAsync failed\n"); return; }
    Args a{};
    for (int i = 0; i < 14; ++i) a.in[i] = (const float*)d_in[i];
    a.out = (float*)d_out; a.ws = (unsigned char*)d_ws;
    if (N_LAUNCHES == PER_PHASE) {
        for (int li = 0; li < PER_PHASE; ++li) { a.ph_lo = li; a.ph_hi = li + 1; a.li = li; hipLaunchKernelGGL(mk_fwd, dim3(grid), dim3(NWAVES * 64), LDS_BYTES, stream, a); }
    } else {
        a.ph_lo = 0; a.ph_hi = PER_PHASE; a.li = 0;
        hipLaunchKernelGGL(mk_fwd, dim3(grid), dim3(NWAVES * 64), LDS_BYTES, stream, a);
    }
    const hipError_t le = hipPeekAtLastError();
    if (le != hipSuccess) fprintf(stderr, "kernel_launch: launch failed: %s\n", hipGetErrorName(le));
}
```

```cpp
#include <hip/hip_runtime.h>
#include <cstdio>
#include <cstdint>
namespace pg8 {
#define PG8_LAS __attribute__((address_space(3)))
typedef unsigned short bf16_t;
typedef short bf16x8 __attribute__((ext_vector_type(8)));
typedef float f32x4 __attribute__((ext_vector_type(4)));
typedef unsigned u32x4 __attribute__((ext_vector_type(4)));
constexpr int BM = 256, BK = 64, HALF = 128, HTB = HALF * BK * 2  , STAGE_BYTES = 8 * HTB, NXCD = 8, WGM = 8;

__host__ __device__ __forceinline__ int lds_byte(int r, int c) { const int st = (r >> 4) * 2 + (c >> 5), rr = r & 15, cc = c & 31, ob = rr * 64 + cc * 2; return st * 1024 + (ob ^ (((ob >> 9) & 1) << 5)); }
__host__ __device__ __forceinline__ void stage_rc(int b, int& R, int& C) { const int st = b / 1024, sb = b % 1024, swz = sb ^ (((sb >> 9) & 1) << 5); R = (st >> 1) * 16 + swz / 64; C = (st & 1) * 32 + (swz % 64) / 2; }
__host__ __device__ __forceinline__ int perm32(int rho) { const int n = rho >> 4, i = rho & 15; return 8 * (i >> 2) + 4 * n + (i & 3); }

struct Unit { int pm, pn; };
struct Gemm { const bf16_t* A; const bf16_t* Bt; int M, N, K; };

struct StaticOrder {
    int nM, nN, nwg, G, c;
    __host__ __device__ void init(int M, int N, int G_, int c_) { nM = M / BM; nN = N / BM; nwg = nM * nN; G = G_; c = c_; }
    __host__ __device__ bool next(int i, Unit& u) const {
        const long L = (long)i * G + c; if (L >= nwg) return false;
        int wgid = (int)L; { const int q = nwg / NXCD, r = nwg % NXCD, xcd = wgid % NXCD, off = wgid / NXCD; wgid = (xcd < r ? xcd * (q + 1) : r * (q + 1) + (xcd - r) * q) + off; }
        const int nig = WGM * nN, gid = wgid / nig, fm = gid * WGM, gsz = (nM - fm) < WGM ? (nM - fm) : WGM;
        u.pm = fm + ((wgid % nig) % gsz); u.pn = (wgid % nig) / gsz; return true;
    }
    __device__ __forceinline__ void a_ready(const Unit&) const {}
    __device__ __forceinline__ void done(const Unit&) const {}
};

__device__ __forceinline__ unsigned cvt_pk_bf16(float lo, float hi) { unsigned r; asm volatile("v_cvt_pk_bf16_f32 %0, %1, %2" : "=v"(r) : "v"(lo), "v"(hi)); return r; }
typedef float f32x2 __attribute__((ext_vector_type(2)));
__device__ __forceinline__ f32x2 gelu_pk(f32x2 v) {
    const f32x2 av = __builtin_elementwise_abs(v), d = av * 0.2316418882f + 1.0f;
    f32x2 t; t.x = __builtin_amdgcn_rcpf(d.x); t.y = __builtin_amdgcn_rcpf(d.y);
    f32x2 q = t * 0.5307027145f + (-0.7265760135f); q = q * t + 0.7107068705f; q = q * t + (-0.142248368f); q = q * t + 0.127414796f; q = q * t;
    const f32x2 s = (v * v) * (-0.72134752044f);
    f32x2 e; e.x = __builtin_amdgcn_exp2f(s.x); e.y = __builtin_amdgcn_exp2f(s.y);
    const f32x2 m = v * (q * e), r = v - m;
    f32x2 o; o.x = v.x < 0.f ? m.x : r.x; o.y = v.y < 0.f ? m.y : r.y; return o;
}

template <int ACT  > struct EpiBf16 {
    static constexpr bool PERM = true, AFTER_DRAIN = false; static_assert(ACT == 0 || ACT == 1, "EpiBf16: ACT is 0 (none) or 1 (gelu_pk)");
    bf16_t* O; int ldc; const float* bias; int split_cols; size_t split_stride; float scale0;
    __device__ __forceinline__ void operator()(const f32x4 (&acc)[2][2][4][2], const Unit& u, int wr, int wc, int fr, int fq) const {
        const int row0 = u.pm * BM + wr * 64 + fr; int colt = u.pn * BM; bf16_t* base = O;
        float sc = 1.f; if (split_cols) { const int t = colt / split_cols; base += (size_t)t * split_stride; colt -= t * split_cols; if (t == 0) sc = scale0; }
        const int col0 = colt + wc * 32 + 8 * fq, bcol0 = u.pn * BM + wc * 32 + 8 * fq;
        f32x4 bv[2][2];
#pragma unroll
        for (int bj = 0; bj < 2; ++bj)
#pragma unroll
            for (int n = 0; n < 2; ++n) bv[bj][n] = bias ? *(const f32x4*)(bias + bcol0 + bj * HALF + 4 * n) : (f32x4){0.f, 0.f, 0.f, 0.f};
#pragma unroll
        for (int ai = 0; ai < 2; ++ai)
#pragma unroll
            for (int m = 0; m < 4; ++m) { bf16_t* rowp = base + (size_t)(row0 + ai * HALF + m * 16) * ldc + col0;
#pragma unroll
                for (int bj = 0; bj < 2; ++bj) { f32x4 v0 = acc[ai][bj][m][0] + bv[bj][0], v1 = acc[ai][bj][m][1] + bv[bj][1];
                    if (ACT == 1) { f32x2 a = gelu_pk((f32x2){v0[0], v0[1]}), b = gelu_pk((f32x2){v0[2], v0[3]}), c = gelu_pk((f32x2){v1[0], v1[1]}), d = gelu_pk((f32x2){v1[2], v1[3]});
                        v0 = (f32x4){a.x, a.y, b.x, b.y}; v1 = (f32x4){c.x, c.y, d.x, d.y}; }
                    v0 = v0 * sc; v1 = v1 * sc; u32x4 w; w.x = cvt_pk_bf16(v0[0], v0[1]); w.y = cvt_pk_bf16(v0[2], v0[3]); w.z = cvt_pk_bf16(v1[0], v1[1]); w.w = cvt_pk_bf16(v1[2], v1[3]);
                    *(u32x4*)(rowp + bj * HALF) = w; } }
    }
};
typedef unsigned u32x2 __attribute__((ext_vector_type(2)));
struct EpiResid {
    static constexpr bool PERM = true, AFTER_DRAIN = false;
    const float* X; bf16_t* X1; float* ssq; int ldc;
    __device__ __forceinline__ void operator()(const f32x4 (&acc)[2][2][4][2], const Unit& u, int wr, int wc, int fr, int fq) const {
        const int row0 = u.pm * BM + wr * 64 + fr, col0 = u.pn * BM + wc * 32 + 8 * fq;
#pragma unroll
        for (int ai = 0; ai < 2; ++ai)
#pragma unroll
            for (int m = 0; m < 4; ++m) { const int row = row0 + ai * HALF + m * 16; const size_t off = (size_t)row * ldc + col0; float s = 0.f;
#pragma unroll
                for (int bj = 0; bj < 2; ++bj) { const f32x4 x0 = *(const f32x4*)(X + off + bj * HALF), x1 = *(const f32x4*)(X + off + bj * HALF + 4);
                    const f32x4 v0 = x0 + acc[ai][bj][m][0], v1 = x1 + acc[ai][bj][m][1];
                    u32x4 w; w.x = cvt_pk_bf16(v0[0], v0[1]); w.y = cvt_pk_bf16(v0[2], v0[3]); w.z = cvt_pk_bf16(v1[0], v1[1]); w.w = cvt_pk_bf16(v1[2], v1[3]);
                    *(u32x4*)(X1 + off + bj * HALF) = w;
                    s += ((v0[0] * v0[0] + v0[1] * v0[1]) + (v0[2] * v0[2] + v0[3] * v0[3])) + ((v1[0] * v1[0] + v1[1] * v1[1]) + (v1[2] * v1[2] + v1[3] * v1[3])); }
                s += __shfl_xor(s, 16); s += __shfl_xor(s, 32);
                if (fq == 0) __hip_atomic_fetch_add(ssq + row, s, __ATOMIC_RELAXED, __HIP_MEMORY_SCOPE_AGENT);
                asm volatile("" ::: "memory"); }
    }
};
struct EpiBf16Rs {
    static constexpr bool PERM = true, AFTER_DRAIN = false;
    bf16_t* O; int ldc; const float* ssq; float inv_n, eps;
    __device__ __forceinline__ void operator()(const f32x4 (&acc)[2][2][4][2], const Unit& u, int wr, int wc, int fr, int fq) const {
        const int row0 = u.pm * BM + wr * 64 + fr;
        const int ks = wc * 2 + (fq >> 1), hi = fq & 1;
#pragma unroll
        for (int ai = 0; ai < 2; ++ai)
#pragma unroll
            for (int m = 0; m < 4; ++m) { const int row = row0 + ai * HALF + m * 16; const float sc = rsqrtf(ssq[row] * inv_n + eps);
#pragma unroll
                for (int bj = 0; bj < 2; ++bj) { const f32x4 v0 = acc[ai][bj][m][0] * sc, v1 = acc[ai][bj][m][1] * sc;
                    u32x4 w; w.x = cvt_pk_bf16(v0[0], v0[1]); w.y = cvt_pk_bf16(v0[2], v0[3]); w.z = cvt_pk_bf16(v1[0], v1[1]); w.w = cvt_pk_bf16(v1[2], v1[3]);
                    const size_t blk = ((((size_t)(row >> 5) * 8 + u.pn) * 2 + bj) * 8 + ks) * 2 + hi;
                    __builtin_nontemporal_store(w, (u32x4*)(O + (blk * 32 + (row & 31)) * 8)); } }
    }
};
struct EpiProj {
    static constexpr bool PERM = true, AFTER_DRAIN = false;
    bf16_t* O; size_t stride; float scale0;
    __device__ __forceinline__ void operator()(const f32x4 (&acc)[2][2][4][2], const Unit& u, int wr, int wc, int fr, int fq) const {
        const int row0 = u.pm * BM + wr * 64 + fr;
        if (u.pn < 4) {
            const int t = u.pn >> 1; bf16_t* base = O + (size_t)t * stride; const float sc = t == 0 ? scale0 : 1.f;
#pragma unroll
            for (int bj = 0; bj < 2; ++bj) { const int col = (u.pn & 1) * BM + bj * HALF + wc * 32 + 8 * fq, head = col >> 6, ks = (col >> 4) & 3, hi = (col >> 3) & 1;
#pragma unroll
                for (int ai = 0; ai < 2; ++ai)
#pragma unroll
                    for (int m = 0; m < 4; ++m) { const int row = row0 + ai * HALF + m * 16; const f32x4 v0 = acc[ai][bj][m][0] * sc, v1 = acc[ai][bj][m][1] * sc;
                        u32x4 w; w.x = cvt_pk_bf16(v0[0], v0[1]); w.y = cvt_pk_bf16(v0[2], v0[3]); w.z = cvt_pk_bf16(v1[0], v1[1]); w.w = cvt_pk_bf16(v1[2], v1[3]);
                        { u32x4* dst_ = (u32x4*)(base + ((((((size_t)(row >> 5) * 8 + head) * 4 + ks) * 2 + hi) * 32 + (row & 31)) * 8)); if (t == 0) __builtin_nontemporal_store(w, dst_); else *dst_ = w; } } }
        } else if (u.pn < 6) {
            const int t = u.pn >> 1; bf16_t* base = O + (size_t)t * stride; const float sc = 1.f;
            const int col0 = (u.pn & 1) * BM + wc * 32 + 8 * fq;
#pragma unroll
            for (int ai = 0; ai < 2; ++ai)
#pragma unroll
                for (int m = 0; m < 4; ++m) { bf16_t* rowp = base + (size_t)(row0 + ai * HALF + m * 16) * 512 + col0;
#pragma unroll
                    for (int bj = 0; bj < 2; ++bj) { const f32x4 v0 = acc[ai][bj][m][0] * sc, v1 = acc[ai][bj][m][1] * sc;
                        u32x4 w; w.x = cvt_pk_bf16(v0[0], v0[1]); w.y = cvt_pk_bf16(v0[2], v0[3]); w.z = cvt_pk_bf16(v1[0], v1[1]); w.w = cvt_pk_bf16(v1[2], v1[3]);
                        *(u32x4*)(rowp + bj * HALF) = w; } }
        } else {
            bf16_t* base = O + 3 * stride; const int ch0 = (u.pn - 6) * HALF + wc * 32 + 8 * fq;
#pragma unroll
            for (int ai = 0; ai < 2; ++ai)
#pragma unroll
                for (int m = 0; m < 4; ++m) { const f32x4 v0 = acc[ai][0][m][0] * acc[ai][1][m][0], v1 = acc[ai][0][m][1] * acc[ai][1][m][1];
                    u32x4 w; w.x = cvt_pk_bf16(v0[0], v0[1]); w.y = cvt_pk_bf16(v0[2], v0[3]); w.z = cvt_pk_bf16(v1[0], v1[1]); w.w = cvt_pk_bf16(v1[2], v1[3]);
                    *(u32x4*)(base + (size_t)(row0 + ai * HALF + m * 16) * 512 + ch0) = w; }
        }
    }
};
struct EpiVT {
    static constexpr bool PERM = true, AFTER_DRAIN = false;
    bf16_t* O;
    __device__ __forceinline__ void operator()(const f32x4 (&acc)[2][2][4][2], const Unit& u, int wr, int wc, int fr, int fq) const {
        const int row0 = u.pm * BM + wr * 64 + fr;
#pragma unroll
        for (int bj = 0; bj < 2; ++bj) { const int tok0 = u.pn * BM + bj * HALF + wc * 32 + 8 * fq, tb = tok0 >> 5, s = (tok0 >> 4) & 1, ab = (tok0 >> 3) & 1;
#pragma unroll
            for (int ai = 0; ai < 2; ++ai)
#pragma unroll
                for (int m = 0; m < 4; ++m) { const int r = row0 + ai * HALF + m * 16, h = r >> 6, db = (r >> 5) & 1, d32 = r & 31;
                    const f32x4 v0 = acc[ai][bj][m][0], v1 = acc[ai][bj][m][1];
                    u32x2 lo, hi2; lo.x = cvt_pk_bf16(v0[0], v0[1]); lo.y = cvt_pk_bf16(v0[2], v0[3]); hi2.x = cvt_pk_bf16(v1[0], v1[1]); hi2.y = cvt_pk_bf16(v1[2], v1[3]);
                    bf16_t* p = O + (((((((size_t)tb * 8 + h) * 2 + db) * 2 + s) * 2 + ab) * 2) * 32 + d32) * 4;
                    *(u32x2*)p = lo; *(u32x2*)(p + 128) = hi2; } }
    }
};
template <class Epi, class Sched, bool ALIGN_EPI = false, bool SP2 = false>
__device__ __forceinline__ void gemm_phase(PG8_LAS unsigned char* lds, const Gemm g, const Sched& S, const Epi& E) {
    const int tid = threadIdx.x, wid = __builtin_amdgcn_readfirstlane(tid >> 6), lane = tid & 63, wr = wid >> 2, wc = wid & 3, fr = lane & 15, fq = lane >> 4;
    const int K = g.K, nt = K / BK;
    unsigned voffA[2], voffB[2];
#pragma unroll
    for (int i = 0; i < 2; ++i) { int R, C; stage_rc(tid * 16 + i * 8192, R, C); const int Rb = Epi::PERM ? ((R & ~31) + perm32(R & 31)) : R;
        voffA[i] = (unsigned)(R * K + C) * 2u; voffB[i] = (unsigned)(Rb * K + C) * 2u; }
    const size_t kstep = (size_t)(BK * 2);
    const size_t hstep = (size_t)HALF * K * 2;
    const size_t tstep = 2 * hstep;
    const unsigned ldsw = (unsigned)wid * 1024u;
    const int aoff = lds_byte(wr * 64 + fr, fq * 8), boff = lds_byte(wc * 32 + fr, fq * 8);
#define PG8_SA(b, h) (((b) * 2 + (h)) * HTB)
#define PG8_SB(b, h) ((4 + (b) * 2 + (h)) * HTB)
#define PG8_STAGE(bufoff, gbase, voff) do { _Pragma("unroll") for (int _i = 0; _i < 2; ++_i) \
        __builtin_amdgcn_global_load_lds((const unsigned*)((const char*)(gbase) + (voff)[_i]), (PG8_LAS unsigned*)(lds + (bufoff) + ldsw + _i * 8192), 16, 0, 0); } while (0)
#define PG8_LDA(dst, b, h) do { _Pragma("unroll") for (int m = 0; m < 4; ++m) _Pragma("unroll") for (int k = 0; k < 2; ++k) dst[m][k] = *(const PG8_LAS bf16x8*)(lds + PG8_SA(b, h) + aoff + m * 2048 + k * 1024); } while (0)
#define PG8_LDB(dst, b, h) do { _Pragma("unroll") for (int n = 0; n < 2; ++n) _Pragma("unroll") for (int k = 0; k < 2; ++k) dst[n][k] = *(const PG8_LAS bf16x8*)(lds + PG8_SB(b, h) + boff + n * 2048 + k * 1024); } while (0)
#define PG8_MMA(ai, bj, At, Bt) do { __builtin_amdgcn_s_setprio(1); _Pragma("unroll") for (int m = 0; m < 4; ++m) _Pragma("unroll") for (int n = 0; n < 2; ++n) _Pragma("unroll") for (int k = 0; k < 2; ++k) \
        acc[ai][bj][m][n] = __builtin_amdgcn_mfma_f32_16x16x32_bf16(Bt[n][k], At[m][k], acc[ai][bj][m][n], 0, 0, 0); __builtin_amdgcn_s_setprio(0); } while (0)
#define PG8_WAIT_V(n) asm volatile("s_waitcnt vmcnt(" #n ")" ::: "memory")
#define PG8_WAIT_L(n) asm volatile("s_waitcnt lgkmcnt(" #n ")" ::: "memory")
#define PG8_BAR __builtin_amdgcn_s_barrier()
#define PG8_SCHED __builtin_amdgcn_sched_barrier(0)
    Unit cur, nxt; int ui = 0;
    if (!S.next(0, cur)) return;
    f32x4 acc[2][2][4][2];
#pragma unroll
    for (int a = 0; a < 2; ++a)
#pragma unroll
        for (int b = 0; b < 2; ++b)
#pragma unroll
            for (int m = 0; m < 4; ++m)
#pragma unroll
                for (int n = 0; n < 2; ++n) acc[a][b][m][n] = (f32x4){0.f, 0.f, 0.f, 0.f};
    bf16x8 At[4][2], B0[2][2], B1[2][2];
    const char* cA = (const char*)g.A + (size_t)cur.pm * tstep; const char* cB = (const char*)g.Bt + (size_t)cur.pn * tstep;
    S.a_ready(cur);
    if constexpr (SP2) {
        PG8_STAGE(PG8_SB(0, 0), cB, voffB); PG8_STAGE(PG8_SB(0, 1), cB + hstep, voffB); PG8_STAGE(PG8_SA(0, 0), cA, voffA); PG8_STAGE(PG8_SA(0, 1), cA + hstep, voffA);
        if (wr == 1) PG8_BAR;
        PG8_WAIT_V(2); PG8_BAR;
        PG8_STAGE(PG8_SB(1, 0), cB + kstep, voffB); PG8_STAGE(PG8_SA(1, 0), cA + kstep, voffA); PG8_STAGE(PG8_SB(1, 1), cB + hstep + kstep, voffB);
        PG8_WAIT_V(6); PG8_BAR;
    } else {
        PG8_STAGE(PG8_SB(0, 0), cB, voffB); PG8_STAGE(PG8_SA(0, 0), cA, voffA); PG8_STAGE(PG8_SB(0, 1), cB + hstep, voffB); PG8_STAGE(PG8_SA(0, 1), cA + hstep, voffA);
        if (wr == 1) PG8_BAR;
        PG8_WAIT_V(4); PG8_BAR;
        PG8_STAGE(PG8_SB(1, 0), cB + kstep, voffB); PG8_STAGE(PG8_SA(1, 0), cA + kstep, voffA); PG8_STAGE(PG8_SB(1, 1), cB + hstep + kstep, voffB);
        PG8_WAIT_V(6); PG8_BAR;
    }
    for (;;) {
        const bool has_next = S.next(ui + 1, nxt);
        const char* nA = has_next ? (const char*)g.A + (size_t)nxt.pm * tstep : cA; const char* nB = has_next ? (const char*)g.Bt + (size_t)nxt.pn * tstep : cB;
        for (int t = 0; t < nt; t += 2) {
            const bool last = (t == nt - 2);
            const char* a1 = cA + (size_t)(t + 1) * kstep;
            const char* a2 = last ? nA : cA + (size_t)(t + 2) * kstep; const char* b2 = last ? nB : cB + (size_t)(t + 2) * kstep;
            const char* a3 = a2 + kstep; const char* b3 = b2 + kstep;
            if (last && has_next) S.a_ready(nxt);
            if constexpr (SP2) {
            PG8_LDB(B0, 0, 0); PG8_LDB(B1, 0, 1); PG8_SCHED; PG8_LDA(At, 0, 0); PG8_STAGE(PG8_SA(1, 1), a1 + hstep, voffA);
            PG8_WAIT_V(8); PG8_WAIT_L(0); PG8_BAR; PG8_MMA(0, 0, At, B0); PG8_MMA(0, 1, At, B1); PG8_BAR; PG8_SCHED;
            PG8_LDA(At, 0, 1); PG8_STAGE(PG8_SB(0, 0), b2, voffB); PG8_STAGE(PG8_SB(0, 1), b2 + hstep, voffB); PG8_STAGE(PG8_SA(0, 0), a2, voffA);
            PG8_WAIT_V(8); PG8_WAIT_L(0); PG8_BAR; PG8_MMA(1, 0, At, B0); PG8_MMA(1, 1, At, B1); PG8_BAR; PG8_SCHED;
            PG8_LDB(B0, 1, 0); PG8_LDB(B1, 1, 1); PG8_SCHED; PG8_LDA(At, 1, 0); PG8_STAGE(PG8_SA(0, 1), a2 + hstep, voffA);
            PG8_WAIT_V(8); PG8_WAIT_L(0); PG8_BAR; PG8_MMA(0, 0, At, B0); PG8_MMA(0, 1, At, B1); PG8_BAR; PG8_SCHED;
            PG8_LDA(At, 1, 1); PG8_STAGE(PG8_SB(1, 0), b3, voffB); PG8_STAGE(PG8_SB(1, 1), b3 + hstep, voffB); PG8_STAGE(PG8_SA(1, 0), a3, voffA);
            PG8_WAIT_V(8); PG8_WAIT_L(0); PG8_BAR; PG8_MMA(1, 0, At, B0); PG8_MMA(1, 1, At, B1); PG8_BAR; PG8_SCHED;
            } else {
            PG8_LDB(B0, 0, 0); PG8_SCHED; PG8_LDA(At, 0, 0); PG8_STAGE(PG8_SA(1, 1), a1 + hstep, voffA);
            PG8_WAIT_L(8); PG8_BAR; PG8_WAIT_L(0); PG8_MMA(0, 0, At, B0); PG8_BAR; PG8_SCHED;
            PG8_LDB(B1, 0, 1); PG8_STAGE(PG8_SB(0, 0), b2, voffB);
            PG8_BAR; PG8_WAIT_L(0); PG8_MMA(0, 1, At, B1); PG8_BAR;
            PG8_LDA(At, 0, 1); PG8_STAGE(PG8_SA(0, 0), a2, voffA);
            PG8_BAR; PG8_WAIT_L(0); PG8_MMA(1, 0, At, B0); PG8_BAR; PG8_SCHED;
            PG8_STAGE(PG8_SB(0, 1), b2 + hstep, voffB);
            PG8_WAIT_V(6); PG8_BAR; PG8_MMA(1, 1, At, B1); PG8_BAR;
            PG8_LDB(B0, 1, 0); PG8_SCHED; PG8_LDA(At, 1, 0); PG8_STAGE(PG8_SA(0, 1), a2 + hstep, voffA);
            PG8_WAIT_L(8); PG8_BAR; PG8_WAIT_L(0); PG8_MMA(0, 0, At, B0); PG8_BAR; PG8_SCHED;
            PG8_LDB(B1, 1, 1); PG8_STAGE(PG8_SB(1, 0), b3, voffB);
            PG8_BAR; PG8_WAIT_L(0); PG8_MMA(0, 1, At, B1); PG8_BAR;
            PG8_LDA(At, 1, 1); PG8_STAGE(PG8_SA(1, 0), a3, voffA);
            PG8_BAR; PG8_WAIT_L(0); PG8_MMA(1, 0, At, B0); PG8_BAR; PG8_SCHED;
            PG8_STAGE(PG8_SB(1, 1), b3 + hstep, voffB);
            PG8_WAIT_V(6); PG8_BAR; PG8_MMA(1, 1, At, B1); PG8_BAR;
            }
        }
        if constexpr (ALIGN_EPI) { if (wr == 0) PG8_BAR; }
        if constexpr (!Epi::AFTER_DRAIN) { E(acc, cur, wr, wc, fr, fq); S.done(cur); }
        if (!has_next) break;
#pragma unroll
        for (int a = 0; a < 2; ++a)
#pragma unroll
            for (int b = 0; b < 2; ++b)
#pragma unroll
                for (int m = 0; m < 4; ++m)
#pragma unroll
                    for (int n = 0; n < 2; ++n) acc[a][b][m][n] = (f32x4){0.f, 0.f, 0.f, 0.f};
        cur = nxt; cA = nA; cB = nB; ++ui;
        if constexpr (ALIGN_EPI) { if (wr == 1) PG8_BAR; }
    }
    PG8_WAIT_V(0);
    if constexpr (!ALIGN_EPI) { if (wr == 0) PG8_BAR; }
    PG8_BAR;
    if constexpr (Epi::AFTER_DRAIN) { E.fused(acc, cur, wr, wc, fr, fq, lds, wid, lane); S.done(cur); }
#undef PG8_SA
#undef PG8_SB
#undef PG8_STAGE
#undef PG8_LDA
#undef PG8_LDB
#undef PG8_MMA
#undef PG8_WAIT_V
#undef PG8_WAIT_L
#undef PG8_BAR
#undef PG8_SCHED
}
}
#ifndef PG8_SP2
#define PG8_SP2 true
#endif
#ifndef PG8_ALIGN
#define PG8_ALIGN true
#endif
constexpr int NWAVES = 8;
#ifndef MK_N_LAUNCHES
#define MK_N_LAUNCHES 1
#endif
constexpr int N_LAUNCHES = MK_N_LAUNCHES;
constexpr int PER_PHASE = 10;

constexpr int BATCH = 16, SEQ = 2048, D = 1024, M = BATCH * SEQ;
constexpr int HW = 512;
constexpr int NHEAD = 8, HD = 64;
constexpr int PEER_H = 8, PEER_DK = 256, DHALF = 128, NKEYS = 128, NEXP = NKEYS * NKEYS, TOPK = 16, NSEL = PEER_H * TOPK;
constexpr float EPS = 1e-6f;
constexpr float QSCALE = 0.125f * 1.4426950408889634f;
constexpr float SB_EXIT = 152.0f;

constexpr size_t MiB = 1u << 20;
constexpr size_t WS_CTL = 0, CTL_ZERO_BYTES = 2 * MiB;
constexpr size_t WS_SSQ1 = 1 * MiB;
constexpr size_t WS_WIN = 2 * MiB, WS_WOUT = 8 * MiB, WS_WQ = 10 * MiB, WS_KEYS = 14 * MiB;
constexpr size_t WS_SSQ2 = 1 * MiB + 256 * 1024;
constexpr size_t WS_SU = 15 * MiB, WS_SV = 15 * MiB + 256 * 1024;
constexpr size_t WS_XS = 15 * MiB + 512 * 1024;
constexpr size_t WS_PFX = 14 * MiB + 512 * 1024;
constexpr size_t WS_XQ = 272 * MiB;
constexpr size_t WS_UQ = 16 * MiB;
constexpr size_t WS_VQ = 32 * MiB;
constexpr size_t WS_XN = 80 * MiB;
constexpr size_t WS_Q = 144 * MiB;
constexpr size_t WS_VTR = 304 * MiB;
constexpr size_t WS_QP = 144 * MiB;
constexpr size_t WS_MIX = 336 * MiB;
constexpr size_t WS_IDX = 400 * MiB, WS_GW = 416 * MiB, WS_W = 432 * MiB, WS_X1B = 448 * MiB, WS_END = 512 * MiB;
constexpr int CW_TMO = 0, CW_CODE = 1;
constexpr int CW_BAR = 4096;
constexpr int CW_TICKET = 8192;

constexpr int RING_OFF = 0, RING_BYTES = 131072;
constexpr int LDSCTL_OFF = RING_BYTES, MISC_OFF = LDSCTL_OFF + 320;
constexpr int LDS_BYTES = 147456;
static_assert(MISC_OFF + 128 <= LDS_BYTES, "LDS map");
#define GAS __attribute__((address_space(1)))
#define LAS __attribute__((address_space(3)))
typedef unsigned short bf16;
typedef unsigned v4u __attribute__((ext_vector_type(4)));
typedef float f32x4 __attribute__((ext_vector_type(4)));
typedef short bf16x8 __attribute__((ext_vector_type(8)));
typedef GAS unsigned gu32;
typedef GAS unsigned long long gu64;
#define RLX_AGENT __ATOMIC_RELAXED, __HIP_MEMORY_SCOPE_AGENT
#define LDS_WAIT() asm volatile("s_waitcnt lgkmcnt(0)" ::: "memory")
#define VM_WAIT() asm volatile("s_waitcnt vmcnt(0)" ::: "memory")
__device__ __forceinline__ unsigned long long rt() { return __builtin_amdgcn_s_memrealtime(); }
__device__ __forceinline__ unsigned f2bf(float f) { unsigned u = __builtin_bit_cast(unsigned, f); return (u + 0x7fffu + ((u >> 16) & 1u)) >> 16; }
__device__ __forceinline__ unsigned pk2(float lo, float hi) { return f2bf(lo) | (f2bf(hi) << 16); }
#define XB_TMO      128
#define XB_XCNT(j)  (256  + 64 * (j))
#define XB_XSUB(j)  (1280 + 64 * (j))
#define XB_XGEN(j)  (2304 + 64 * (j))
#define XB_TOP      3328
#define XB_TOPGEN   3392
#define XCD_BAR_WORDS 3456
#define XB_SPIN_CAP (1u << 18)

__device__ __forceinline__ unsigned xb_ld(unsigned* p)              { return __hip_atomic_load(p, __ATOMIC_RELAXED, __HIP_MEMORY_SCOPE_AGENT); }
__device__ __forceinline__ unsigned xb_add(unsigned* p, unsigned v) { return __hip_atomic_fetch_add(p, v, __ATOMIC_RELAXED, __HIP_MEMORY_SCOPE_AGENT); }
__device__ __forceinline__ unsigned xb_xcc_id() { return (unsigned)__builtin_amdgcn_s_getreg((3 << 11) | 20) & 0xFu; }
#define XB_SPIN(cond, bar) do { unsigned _sp = 0; while (cond) { __builtin_amdgcn_s_sleep(1); \
    if ((++_sp & 255u) == 0u) { if (xb_ld(&(bar)[XB_TMO])) break; if (_sp > XB_SPIN_CAP) { atomicAdd(&(bar)[XB_TMO], 1u); break; } } } } while (0)

struct XcdBarrier {
    unsigned* bar; unsigned x;
    volatile LAS unsigned* st;
};

__device__ __forceinline__ XcdBarrier xcd_barrier_post(unsigned* bar, volatile LAS unsigned* st) {
    XcdBarrier b; b.bar = bar; b.x = xb_xcc_id(); b.st = st;
    if (threadIdx.x == 0) (void)xb_add(&bar[XB_XCNT(b.x)], 1u);
    return b;
}
__device__ __forceinline__ void xcd_barrier_complete(unsigned* bar, unsigned x, unsigned& nloc, unsigned& nx) {
    const unsigned G = gridDim.x * gridDim.y * gridDim.z;
    unsigned sum, cnt, mine, sp = 0u;
    for (;;) {
        sum = 0u; cnt = 0u; mine = 0u;
#pragma unroll
        for (unsigned j = 0; j < 16; ++j) { const unsigned c = xb_ld(&bar[XB_XCNT(j)]); sum += c; cnt += (c > 0u) ? 1u : 0u; mine = (j == x) ? c : mine; }
        if (sum == G) break;
        __builtin_amdgcn_s_sleep(1);
        if ((++sp & 255u) == 0u) { if (xb_ld(&bar[XB_TMO])) break; if (sp > XB_SPIN_CAP) { atomicAdd(&bar[XB_TMO], 1u); break; } }
    }
    nloc = mine > 0u ? mine : 1u; nx = cnt > 0u ? cnt : 1u;
}

__device__ __forceinline__ void xcd_barrier(const XcdBarrier& b) {
    asm volatile("s_waitcnt vmcnt(0)" ::: "memory");
    __syncthreads();
    if (threadIdx.x == 0) {
        unsigned* bar = b.bar;
        __builtin_amdgcn_s_waitcnt(0);
        unsigned nloc = b.st[0], nx = b.st[1];
        if (nloc == 0u) { xcd_barrier_complete(bar, b.x, nloc, nx); b.st[0] = nloc; b.st[1] = nx; }
        const unsigned old = xb_add(&bar[XB_XSUB(b.x)], 1u);
        const unsigned gen = old / nloc;
        if (old + 1u == (gen + 1u) * nloc) {
            __builtin_amdgcn_fence(__ATOMIC_RELEASE, "agent");
            asm volatile("s_waitcnt vmcnt(0)" ::: "memory");
            const unsigned og = xb_add(&bar[XB_TOP], 1u);
            const unsigned tg = og / nx;
            if (og + 1u == (tg + 1u) * nx) xb_add(&bar[XB_TOPGEN], 1u);
            else XB_SPIN(xb_ld(&bar[XB_TOPGEN]) == tg, bar);
            __builtin_amdgcn_fence(__ATOMIC_ACQUIRE, "agent");
            xb_add(&bar[XB_XGEN(b.x)], 1u);
            asm volatile("s_waitcnt vmcnt(0)" ::: "memory");
        } else {
            XB_SPIN(xb_ld(&bar[XB_XGEN(b.x)]) == gen, bar);
            __builtin_amdgcn_fence(__ATOMIC_ACQUIRE, "agent");
            asm volatile("s_waitcnt vmcnt(0)" ::: "memory");
        }
    }
    __syncthreads();
}

typedef float f32x16 __attribute__((ext_vector_type(16)));
typedef short s16x4 __attribute__((ext_vector_type(4)));
typedef unsigned v2u __attribute__((ext_vector_type(2)));
struct Frame {
    LAS unsigned char* lds;
    volatile LAS unsigned* MISC;
    gu32* ctl;
    int tid, lane, wave;
    int vcu, G;
    const float *x, *mix_g, *w_in, *conv_w, *conv_b, *attn_g, *conv_g, *w_out, *ffn_g, *wq, *keys, *pu, *pv, *fin_g;
    float* out;
    bf16 *WinT, *WoutT, *WqT, *KEYSB, *XN, *Q, *K, *GB, *UU, *VTR, *QP, *MIX;
    unsigned char *UQ, *VQ, *XQ; bf16 *X2B, *X1B; float *SU, *SV, *XS;
    float *SSQ1; unsigned *IG, *IGS, *PFX, *WP;
};

__device__ __forceinline__ int lane_id() { return (int)__builtin_amdgcn_mbcnt_hi(~0u, __builtin_amdgcn_mbcnt_lo(~0u, 0u)); }
template <int CTRL> __device__ __forceinline__ float dppf(float v) { return __int_as_float(__builtin_amdgcn_update_dpp(0, __float_as_int(v), CTRL, 0xf, 0xf, false)); }
__device__ __forceinline__ float swz16f(float v) { return __int_as_float(__builtin_amdgcn_ds_swizzle(__float_as_int(v), 0x1f | (16 << 10))); }
__device__ __forceinline__ float wave_sum(float v) {
    v += dppf<0xb1>(v); v += dppf<0x4e>(v); v += dppf<0x141>(v); v += dppf<0x128>(v); v += swz16f(v);
    auto rr = __builtin_amdgcn_permlane32_swap(__float_as_uint(v), __float_as_uint(v), false, false); return __uint_as_float(rr[0]) + __uint_as_float(rr[1]);
}
__device__ __forceinline__ float wave_max(float v) {
    v = __builtin_fmaxf(v, dppf<0xb1>(v)); v = __builtin_fmaxf(v, dppf<0x4e>(v)); v = __builtin_fmaxf(v, dppf<0x141>(v)); v = __builtin_fmaxf(v, dppf<0x128>(v)); v = __builtin_fmaxf(v, swz16f(v));
    auto rr = __builtin_amdgcn_permlane32_swap(__float_as_uint(v), __float_as_uint(v), false, false); return __builtin_fmaxf(__uint_as_float(rr[0]), __uint_as_float(rr[1]));
}
__device__ __forceinline__ float bf_lo(unsigned w) { return __uint_as_float(w << 16); }
__device__ __forceinline__ float bf_hi(unsigned w) { return __uint_as_float(w & 0xffff0000u); }
typedef float f32x2_t __attribute__((ext_vector_type(2))); typedef __bf16 bf16x2_t __attribute__((ext_vector_type(2))); typedef _Float16 h2_t __attribute__((ext_vector_type(2)));
__device__ __forceinline__ unsigned cvtpk(float lo, float hi) { f32x2_t v = {lo, hi}; bf16x2_t b = __builtin_convertvector(v, bf16x2_t); return __builtin_bit_cast(unsigned, b); }

__device__ __forceinline__ void p0_transpose_item(const float* W, int ldw, int K, int ncols, bf16* WT, int row_off, LAS float* scr, int item, int lane, const float* kgain = nullptr) {
    const int nblk = ncols / 32, kb = item / nblk, nb = item % nblk, k0 = 64 * kb, n0 = 32 * nb;
#pragma unroll 8
    for (int i = 0; i < 32; ++i) { const int kk = 2 * i + (lane >> 5); const float gk = kgain ? kgain[k0 + kk] : 1.f; scr[kk * 33 + (lane & 31)] = gk * W[(size_t)(k0 + kk) * ldw + n0 + (lane & 31)]; }
    LDS_WAIT(); asm volatile("" ::: "memory");
    const int c = lane & 7;
#pragma unroll
    for (int j = 0; j < 4; ++j) { const int n = (lane >> 3) + 8 * j; const LAS float* s = scr + (8 * c) * 33 + n;
        v4u o; o.x = pk2(s[0 * 33], s[1 * 33]); o.y = pk2(s[2 * 33], s[3 * 33]); o.z = pk2(s[4 * 33], s[5 * 33]); o.w = pk2(s[6 * 33], s[7 * 33]);
        *(GAS v4u*)(WT + (size_t)(row_off + n0 + n) * K + k0 + 8 * c) = o; }
    LDS_WAIT(); asm volatile("" ::: "memory");
}
__device__ __forceinline__ void p0_convert(const float* src, bf16* dst, size_t n8, size_t gt, size_t NGT) {
    for (size_t i = gt; i < n8; i += NGT) {
        const f32x4 a = ((const GAS f32x4*)src)[2 * i], b = ((const GAS f32x4*)src)[2 * i + 1];
        v4u o; o.x = pk2(a.x, a.y); o.y = pk2(a.z, a.w); o.z = pk2(b.x, b.y); o.w = pk2(b.z, b.w);
        ((GAS v4u*)dst)[i] = o; }
}
__device__ __forceinline__ void rms_rows2_to_bf16(Frame& F, const float* x0, const float* x1, const float* g, bf16* o0, bf16* o1, bool ok1) {
    const GAS f32x4* xr0 = (const GAS f32x4*)x0 + F.lane; const GAS f32x4* xr1 = (const GAS f32x4*)x1 + F.lane; const GAS f32x4* gr = (const GAS f32x4*)g + F.lane;
    f32x4 v[4], w[4]; float s = 0.f, t = 0.f;
#pragma unroll
    for (int j = 0; j < 4; ++j) { v[j] = __builtin_nontemporal_load(xr0 + 64 * j); w[j] = __builtin_nontemporal_load(xr1 + 64 * j); }
#pragma unroll
    for (int j = 0; j < 4; ++j) { s += (v[j].x * v[j].x + v[j].y * v[j].y) + (v[j].z * v[j].z + v[j].w * v[j].w); t += (w[j].x * w[j].x + w[j].y * w[j].y) + (w[j].z * w[j].z + w[j].w * w[j].w); }
    const float r0 = rsqrtf(wave_sum(s) * (1.f / D) + EPS), r1 = rsqrtf(wave_sum(t) * (1.f / D) + EPS);
    GAS unsigned long long* p0 = (GAS unsigned long long*)o0 + F.lane; GAS unsigned long long* p1 = (GAS unsigned long long*)o1 + F.lane;
#pragma unroll
    for (int j = 0; j < 4; ++j) { const f32x4 gg = gr[64 * j];
        p0[64 * j] = (unsigned long long)pk2(v[j].x * r0 * gg.x, v[j].y * r0 * gg.y) | ((unsigned long long)pk2(v[j].z * r0 * gg.z, v[j].w * r0 * gg.w) << 32);
        if (ok1) p1[64 * j] = (unsigned long long)pk2(w[j].x * r1 * gg.x, w[j].y * r1 * gg.y) | ((unsigned long long)pk2(w[j].z * r1 * gg.z, w[j].w * r1 * gg.w) << 32); }
}
__device__ __forceinline__ void p0_quant_row(Frame& F, const f32x4 (&v)[4], int e) {
    const bool isv = e >= NEXP; const int r = isv ? e - NEXP : e;
    float am = 0.f;
#pragma unroll
    for (int j = 0; j < 4; ++j) { am = __builtin_fmaxf(am, __builtin_fmaxf(__builtin_fmaxf(__builtin_fabsf(v[j].x), __builtin_fabsf(v[j].y)), __builtin_fmaxf(__builtin_fabsf(v[j].z), __builtin_fabsf(v[j].w)))); }
    am = wave_max(am);
    const float qmax = isv ? 440.f : 127.f;
    const float inv = am > 0.f ? qmax / am : 0.f;
    v4u o;
    if (isv) {
#pragma unroll
        for (int j = 0; j < 4; ++j) { int p = __builtin_amdgcn_cvt_pk_fp8_f32(v[j].x * inv, v[j].y * inv, 0, false); p = __builtin_amdgcn_cvt_pk_fp8_f32(v[j].z * inv, v[j].w * inv, p, true); o[j] = (unsigned)p; }
#pragma unroll
        for (int j = 0; j < 4; ++j) __builtin_nontemporal_store(o[j], (GAS unsigned*)(F.VQ + ((size_t)(2 * j + (F.lane >> 5)) * NEXP + r) * 128 + 4 * (F.lane & 31)));
    } else {
#pragma unroll
        for (int j = 0; j < 4; ++j) { const int q0 = (int)__builtin_rintf(v[j].x * inv), q1 = (int)__builtin_rintf(v[j].y * inv), q2 = (int)__builtin_rintf(v[j].z * inv), q3 = (int)__builtin_rintf(v[j].w * inv);
            o[j] = (unsigned)(q0 & 255) | ((unsigned)(q1 & 255) << 8) | ((unsigned)(q2 & 255) << 16) | ((unsigned)(q3 & 255) << 24); }
#pragma unroll
        for (int j = 0; j < 4; ++j) __builtin_nontemporal_store(o[j], (GAS unsigned*)(F.UQ + (size_t)r * D + 256 * j + 4 * F.lane));
    }
    if (F.lane == 0) F.SU[2 * r + (isv ? 1 : 0)] = am > 0.f ? am / qmax : 1.f;
}
#ifndef MK_QSPLIT
#define MK_QSPLIT 24576
#endif
constexpr int Q_SPLIT = MK_QSPLIT;
__device__ __forceinline__ void p0_quant_rows(Frame& F, const int gw, const int NGW, const int e_lo, const int e_hi) {
    constexpr int QG = 4;
    const int nrows = e_lo + gw < e_hi ? (e_hi - e_lo - gw + NGW - 1) / NGW : 0;
#define P0_QLOAD(buf, i0_) do { _Pragma("unroll") for (int q_ = 0; q_ < QG; ++q_) { const int i_ = (i0_) + q_ < nrows ? (i0_) + q_ : (nrows > 0 ? nrows - 1 : 0); const int e_ = nrows > 0 ? e_lo + gw + i_ * NGW : 0; \
        const GAS f32x4* src_ = (const GAS f32x4*)((e_ >= NEXP ? F.pv : F.pu) + (size_t)(e_ >= NEXP ? e_ - NEXP : e_) * D) + F.lane; \
        _Pragma("unroll") for (int j_ = 0; j_ < 4; ++j_) buf[q_][j_] = __builtin_nontemporal_load(src_ + 64 * j_); } } while (0)
#define P0_QROWS(buf, i0_) do { _Pragma("unroll") for (int q_ = 0; q_ < QG; ++q_) { if ((i0_) + q_ < nrows) p0_quant_row(F, buf[q_], e_lo + gw + ((i0_) + q_) * NGW); } } while (0)
    f32x4 qa[QG][4], qb[QG][4];
    if (nrows > 0) P0_QLOAD(qa, 0);
    for (int i0 = 0; i0 < nrows; i0 += 2 * QG) {
        if (i0 + QG < nrows) P0_QLOAD(qb, i0 + QG);
        P0_QROWS(qa, i0);
        if (i0 + 2 * QG < nrows) P0_QLOAD(qa, i0 + 2 * QG);
        P0_QROWS(qb, i0 + QG);
    }
#undef P0_QLOAD
#undef P0_QROWS
}
template <int PART> __device__ __forceinline__ void p0_prologue(Frame& F, const int gw, const int NGW) {
    LAS float* scr = (LAS float*)(F.lds + RING_OFF + (PART ? 49152 + F.wave * 10240 : F.wave * 16384));
    constexpr int I0 = (D / 64) * (1024 / 32), I1 = (D / 64) * (512 / 32), I2 = (D / 64) * (512 / 32), IG = (D / 64) * (128 / 32), I3 = (D / 64) * (D / 32), I4 = (D / 64) * (2048 / 32);
    constexpr int NITEMS = I0 + I1 + I2 + 8 * IG + I3 + I4;
    constexpr int NIN = I0 + I1 + I2 + 8 * IG;
    for (int it = (PART ? NIN : 0) + gw; it < (PART ? NITEMS : NIN); it += NGW) {
        int r = it;
        if (r < I0) { p0_transpose_item(F.w_in, 3072, D, 1024, F.WinT, 0, scr, r, F.lane); continue; } r -= I0;
        if (r < I1) { p0_transpose_item(F.w_in + 1024, 3072, D, 512, F.WinT, 2560, scr, r, F.lane); continue; } r -= I1;
        if (r < I2) { p0_transpose_item(F.w_in + 1536, 3072, D, 512, F.WinT, 1024, scr, r, F.lane); continue; } r -= I2;
        if (r < 8 * IG) { const int seg = r / IG, T = seg >> 1, ishc = seg & 1;
            p0_transpose_item(F.w_in + 2048 + 512 * ishc + 128 * T, 3072, D, 128, F.WinT, 1536 + 256 * T + 128 * ishc, scr, r % IG, F.lane); continue; } r -= 8 * IG;
        if (r < I3) { p0_transpose_item(F.w_out, D, D, D, F.WoutT, 0, scr, r, F.lane); continue; } r -= I3;
        p0_transpose_item(F.wq, 2048, D, 2048, F.WqT, 0, scr, r, F.lane, F.ffn_g);
    }
    if (PART == 0) {
        for (int m = gw; m < M; m += 2 * NGW) { const bool ok1 = m + NGW < M; const int m1 = ok1 ? m + NGW : m;
            rms_rows2_to_bf16(F, F.x + (size_t)m * D, F.x + (size_t)m1 * D, F.mix_g, F.XN + (size_t)m * D, F.XN + (size_t)m1 * D, ok1); }
        return;
    }
    const size_t gt = (size_t)gw * 64 + F.lane, NGT = (size_t)NGW * 64;
    p0_convert(F.keys, F.KEYSB, (size_t)2 * PEER_H * NKEYS * DHALF / 8, gt, NGT);
    p0_quant_rows(F, gw, NGW, 0, Q_SPLIT);
}

__device__ __forceinline__ int crow(int r, int hi) { return (r & 3) + 8 * (r >> 2) + 4 * hi; }
constexpr int ATT_WAVES = 4;
__device__ __forceinline__ void attn_head_tiles(Frame& F, const int h, const size_t brow, const int qb, const int lane, f32x16& o0_out, f32x16& o1_out) {
    const int q32 = lane & 31, hi = lane >> 5, t0 = qb * 32;
        bf16x8 qf[4];
        { const bf16* Qp = F.Q + ((((brow + t0) >> 5) * 8 + h) * 8 * 32 + hi * 32 + q32) * 8;
#pragma unroll
          for (int ks = 0; ks < 4; ++ks) qf[ks] = *(const bf16x8*)(Qp + ks * 512); }
        f32x16 o0 = {}, o1 = {}; float c = 0.f;
        const bf16* const Kb = F.K + (((brow >> 5) * 8 + h) * 8 * 32 + hi * 32 + q32) * 8;
        const bf16* const Vb = F.VTR + (((brow >> 5) * 8 + h) * 16 * 32 + hi * 32 + q32) * 4;
#define ATT_LOAD(KF, VA, VB, key0_) do { const size_t to_ = (size_t)((key0_) >> 5) * (8 * 2048); \
            _Pragma("unroll") for (int ks = 0; ks < 4; ++ks) KF[ks] = *(const bf16x8*)(Kb + to_ + ks * 512); \
            _Pragma("unroll") for (int db = 0; db < 2; ++db) _Pragma("unroll") for (int s_ = 0; s_ < 2; ++s_) { \
                VA[db][s_] = *(const s16x4*)(Vb + to_ + ((db * 2 + s_) * 2 + 0) * 256); VB[db][s_] = *(const s16x4*)(Vb + to_ + ((db * 2 + s_) * 2 + 1) * 256); } } while (0)
        struct KV { bf16x8 k[4]; s16x4 va[2][2], vb[2][2]; };
        KV A, B, C;
        ATT_LOAD(A.k, A.va, A.vb, qb * 32);
        { const int kp = qb > 0 ? qb - 1 : 0; ATT_LOAD(B.k, B.va, B.vb, kp * 32); }
        auto step = [&](const KV& X, KV& Y, const int kt) -> bool {
            { const int kp = kt > 1 ? kt - 2 : 0; ATT_LOAD(Y.k, Y.va, Y.vb, kp * 32); }
            f32x16 S = {};
#pragma unroll
            for (int ks = 0; ks < 4; ++ks) S = __builtin_amdgcn_mfma_f32_32x32x16_bf16(X.k[ks], qf[ks], S, 0, 0, 0);
            const bool diag = (kt == qb);
            float lm[16], zz[16];
#pragma unroll
            for (int r = 0; r < 16; ++r) {
                const float z = S[r];
                const float e = __builtin_amdgcn_exp2f(-__builtin_fabsf(z));
                const float sp = __builtin_fmaxf(z, 0.f) + __builtin_amdgcn_logf(1.0f + e);
                const bool valid = !diag || (crow(r, hi) < q32);
                lm[r] = valid ? -sp : 0.f; zz[r] = z - sp;
            }
            float suf[16], T[4];
#pragma unroll
            for (int g = 0; g < 4; ++g) { suf[4 * g + 3] = 0.f; suf[4 * g + 2] = lm[4 * g + 3]; suf[4 * g + 1] = suf[4 * g + 2] + lm[4 * g + 2]; suf[4 * g] = suf[4 * g + 1] + lm[4 * g + 1]; T[g] = suf[4 * g] + lm[4 * g]; }
            float Lh[4], Hh[4];
#pragma unroll
            for (int g = 0; g < 4; ++g) { auto rr = __builtin_amdgcn_permlane32_swap(__float_as_uint(T[g]), __float_as_uint(T[g]), false, false); Lh[g] = __uint_as_float(rr[0]); Hh[g] = __uint_as_float(rr[1]); }
            float A[4]; A[3] = 0.f;
#pragma unroll
            for (int g = 2; g >= 0; --g) A[g] = A[g + 1] + (Lh[g + 1] + Hh[g + 1]);
            const float total = A[0] + (Lh[0] + Hh[0]);
            float a[16];
#pragma unroll
            for (int r = 0; r < 16; ++r) {
                const int g = r >> 2;
                const float E = A[g] + (hi ? 0.f : Hh[g]);
                const float arg = zz[r] + suf[r] + E + c;
                const bool valid = !diag || (crow(r, hi) < q32);
                a[r] = valid ? __builtin_amdgcn_exp2f(arg) : 0.f;
            }
            c += total;
#pragma unroll
            for (int s = 0; s < 2; ++s) {
                v4u pw; pw.x = cvtpk(a[8 * s], a[8 * s + 1]); pw.y = cvtpk(a[8 * s + 2], a[8 * s + 3]); pw.z = cvtpk(a[8 * s + 4], a[8 * s + 5]); pw.w = cvtpk(a[8 * s + 6], a[8 * s + 7]);
                const bf16x8 pb = __builtin_bit_cast(bf16x8, pw);
                const bf16x8 v0 = (bf16x8){X.va[0][s][0], X.va[0][s][1], X.va[0][s][2], X.va[0][s][3], X.vb[0][s][0], X.vb[0][s][1], X.vb[0][s][2], X.vb[0][s][3]};
                const bf16x8 v1 = (bf16x8){X.va[1][s][0], X.va[1][s][1], X.va[1][s][2], X.va[1][s][3], X.vb[1][s][0], X.vb[1][s][1], X.vb[1][s][2], X.vb[1][s][3]};
                o0 = __builtin_amdgcn_mfma_f32_32x32x16_bf16(v0, pb, o0, 0, 0, 0);
                o1 = __builtin_amdgcn_mfma_f32_32x32x16_bf16(v1, pb, o1, 0, 0, 0);
            }
            return __all(c < -SB_EXIT);
        };
        for (int kt = qb;;) {
            if (step(A, C, kt) || --kt < 0) break;
            if (step(B, A, kt) || --kt < 0) break;
            if (step(C, B, kt) || --kt < 0) break;
        }
#undef ATT_LOAD
        o0_out = o0; o1_out = o1;
}
__device__ __forceinline__ void att_sync(volatile LAS unsigned* cnt, unsigned target, int lane) {
    LDS_WAIT();
    if (lane == 0) (void)__hip_atomic_fetch_add((LAS unsigned*)cnt, 1u, __ATOMIC_RELAXED, __HIP_MEMORY_SCOPE_WORKGROUP);
    while (*cnt < target) __builtin_amdgcn_s_sleep(1);
    asm volatile("" ::: "memory");
}
__device__ __forceinline__ void attn_store_head(Frame& F, const int h, const f32x16& o0, const f32x16& o1, const float rinv, const size_t brow, const int t0, const int lane) {
    const int q32 = lane & 31, hi = lane >> 5;
        LAS unsigned char* stg = F.lds + RING_OFF + 4096 + F.wave * 4608;
        const float* gp = F.attn_g + h * HD + 4 * hi;
#pragma unroll
        for (int db = 0; db < 2; ++db)
#pragma unroll
            for (int g = 0; g < 4; ++g) {
                const f32x4 gg = *(const f32x4*)(gp + db * 32 + 8 * g);
                const f32x16& o = db ? o1 : o0;
                v2u w; w.x = cvtpk(o[4 * g] * rinv * gg.x, o[4 * g + 1] * rinv * gg.y); w.y = cvtpk(o[4 * g + 2] * rinv * gg.z, o[4 * g + 3] * rinv * gg.w);
                *(LAS v2u*)(stg + q32 * 136 + (db * 32 + 8 * g + 4 * hi) * 2) = w;
            }
        LDS_WAIT();
#pragma unroll
        for (int p = 0; p < 4; ++p) { const int row = 8 * p + (lane >> 3);
            const v2u a = *(const LAS v2u*)(stg + row * 136 + (lane & 7) * 16), b = *(const LAS v2u*)(stg + row * 136 + (lane & 7) * 16 + 8);
            v4u w; w.x = a.x; w.y = a.y; w.z = b.x; w.w = b.y;
            *(v4u*)(F.MIX + (brow + t0 + row) * D + h * HD + (lane & 7) * 8) = w; }
        LDS_WAIT();
}
__device__ __forceinline__ void attn_phase(Frame& F) {
    const int lane = F.lane, q32 = lane & 31, hi = lane >> 5, w = F.wave;
    LAS float* ssq_lds = (LAS float*)(F.lds + RING_OFF);
    volatile LAS unsigned* cnt = (volatile LAS unsigned*)(F.lds + RING_OFF + 2048);
    constexpr int NUNIT = BATCH * (SEQ / 32);
    int par = 0; unsigned visit = 0u;
    for (int unit = F.vcu; unit < NUNIT; unit += F.G, par ^= 1) {
        const int b = unit >> 6, qb = unit & 63;
        const size_t brow = (size_t)b * SEQ; const int t0 = qb * 32;
        f32x16 oa0, oa1, ob0, ob1;
        attn_head_tiles(F, w, brow, qb, lane, oa0, oa1);
        attn_head_tiles(F, w + ATT_WAVES, brow, qb, lane, ob0, ob1);
        float sq = 0.f;
#pragma unroll
        for (int r = 0; r < 16; ++r) sq += (oa0[r] * oa0[r] + oa1[r] * oa1[r]) + (ob0[r] * ob0[r] + ob1[r] * ob1[r]);
        { auto rr = __builtin_amdgcn_permlane32_swap(__float_as_uint(sq), __float_as_uint(sq), false, false); sq = __uint_as_float(rr[0]) + __uint_as_float(rr[1]); }
        if (hi == 0) ssq_lds[(par * ATT_WAVES + w) * 32 + q32] = sq;
        visit += ATT_WAVES; att_sync(cnt, visit, lane);
        float tot = 0.f;
#pragma unroll
        for (int k = 0; k < ATT_WAVES; ++k) tot += ssq_lds[(par * ATT_WAVES + k) * 32 + q32];
        const float rinv = rsqrtf(tot * (1.f / HW) + EPS);
        attn_store_head(F, w, oa0, oa1, rinv, brow, t0, lane);
        attn_store_head(F, w + ATT_WAVES, ob0, ob1, rinv, brow, t0, lane);
    }
}
__device__ __forceinline__ void conv_phase(Frame& F, const int gw, const int NGW) {
    const int c8 = F.lane * 8;
    float w0[8], w1[8], w2[8], bb[8], gg[8];
#pragma unroll
    for (int i = 0; i < 8; ++i) { w0[i] = F.conv_w[c8 + i]; w1[i] = F.conv_w[HW + c8 + i]; w2[i] = F.conv_w[2 * HW + c8 + i]; bb[i] = F.conv_b[c8 + i]; gg[i] = F.conv_g[c8 + i]; }
    constexpr int RUN = 16;
    for (int chunk = gw; chunk < M / RUN; chunk += NGW) {
        const int r0 = chunk * RUN, t0 = r0 & (SEQ - 1);
        float u1[8], u2[8];
#pragma unroll
        for (int i = 0; i < 8; ++i) { u1[i] = 0.f; u2[i] = 0.f; }
        if (t0 >= 2) {
            const size_t off = (size_t)r0 * HW + c8;
            const v4u a1 = *(const v4u*)(F.UU + off - HW), a2 = *(const v4u*)(F.UU + off - 2 * HW);
#pragma unroll
            for (int i = 0; i < 4; ++i) { u1[2 * i] = bf_lo(a1[i]); u1[2 * i + 1] = bf_hi(a1[i]); u2[2 * i] = bf_lo(a2[i]); u2[2 * i + 1] = bf_hi(a2[i]); }
        }
        v4u gball[RUN], uall[RUN];
#pragma unroll
        for (int k = 0; k < RUN; ++k) { gball[k] = __builtin_nontemporal_load((const v4u*)(F.GB + (size_t)(r0 + k) * HW + c8)); uall[k] = __builtin_nontemporal_load((const v4u*)(F.UU + (size_t)(r0 + k) * HW + c8)); }
#pragma unroll
        for (int k = 0; k < RUN; ++k) {
            const v4u gbv = gball[k], uv = uall[k];
            const int row = r0 + k;
            float oc[8], u0[8]; float s = 0.f;
#pragma unroll
            for (int i = 0; i < 4; ++i) {
                u0[2 * i] = bf_lo(uv[i]); u0[2 * i + 1] = bf_hi(uv[i]);
                const float yl = w0[2 * i] * u2[2 * i] + w1[2 * i] * u1[2 * i] + w2[2 * i] * u0[2 * i] + bb[2 * i];
                const float yh = w0[2 * i + 1] * u2[2 * i + 1] + w1[2 * i + 1] * u1[2 * i + 1] + w2[2 * i + 1] * u0[2 * i + 1] + bb[2 * i + 1];
                oc[2 * i] = bf_lo(gbv[i]) * yl; oc[2 * i + 1] = bf_hi(gbv[i]) * yh;
                s += oc[2 * i] * oc[2 * i] + oc[2 * i + 1] * oc[2 * i + 1];
            }
            const float rinv = rsqrtf(wave_sum(s) * (1.f / HW) + EPS);
            v4u o;
            o.x = cvtpk(oc[0] * rinv * gg[0], oc[1] * rinv * gg[1]); o.y = cvtpk(oc[2] * rinv * gg[2], oc[3] * rinv * gg[3]);
            o.z = cvtpk(oc[4] * rinv * gg[4], oc[5] * rinv * gg[5]); o.w = cvtpk(oc[6] * rinv * gg[6], oc[7] * rinv * gg[7]);
            __builtin_nontemporal_store(o, (v4u*)(F.MIX + (size_t)row * D + HW + c8));
#pragma unroll
            for (int i = 0; i < 8; ++i) { u2[i] = u1[i]; u1[i] = u0[i]; }
        }
    }
}

__device__ __forceinline__ unsigned f2sortable(float f) { const unsigned u = __float_as_uint(f); return u ^ ((unsigned)((int)u >> 31) | 0x80000000u); }
__device__ __forceinline__ float sortable2f(unsigned s) { const unsigned u = (s & 0x80000000u) ? (s ^ 0x80000000u) : ~s; return __uint_as_float(u); }
__device__ __forceinline__ unsigned umax_(unsigned a, unsigned b) { return a > b ? a : b; }
__device__ __forceinline__ unsigned umin_(unsigned a, unsigned b) { return a < b ? a : b; }
struct Net16 { int i[63], j[63]; };
constexpr Net16 OE16 = { { 0, 2, 0, 1, 1, 4, 6, 4, 5, 5, 0, 2, 2, 1, 3, 3, 1, 3, 5, 8, 10, 8, 9, 9, 12, 14, 12, 13, 13, 8, 10, 10, 9, 11, 11, 9, 11, 13, 0, 4, 4, 2, 6, 6, 2, 6, 10, 1, 5, 5, 3, 7, 7, 3, 7, 11, 1, 3, 5, 7, 9, 11, 13 }, { 1, 3, 2, 3, 2, 5, 7, 6, 7, 6, 4, 6, 4, 5, 7, 5, 2, 4, 6, 9, 11, 10, 11, 10, 13, 15, 14, 15, 14, 12, 14, 12, 13, 15, 13, 10, 12, 14, 8, 12, 8, 10, 14, 10, 4, 8, 12, 9, 13, 9, 11, 15, 11, 5, 9, 13, 2, 4, 6, 8, 10, 12, 14 } };
__device__ __forceinline__ void sort16(unsigned (&a)[16]) {
#pragma unroll
    for (int c = 0; c < 63; ++c) { const unsigned mx = umax_(a[OE16.i[c]], a[OE16.j[c]]), mn = umin_(a[OE16.i[c]], a[OE16.j[c]]); a[OE16.i[c]] = mx; a[OE16.j[c]] = mn; }
}
__device__ __forceinline__ void merge16(unsigned (&a)[16], const unsigned (&b)[16]) {
#pragma unroll
    for (int i = 0; i < 16; ++i) a[i] = umax_(a[i], b[15 - i]);
#pragma unroll
    for (int j = 8; j > 0; j >>= 1)
#pragma unroll
        for (int i = 0; i < 16; ++i) { const int l = i ^ j; if (l > i) { const unsigned mx = umax_(a[i], a[l]), mn = umin_(a[i], a[l]); a[i] = mx; a[l] = mn; } }
}
__device__ __forceinline__ void merge_halves(unsigned (&a)[16]) {
    unsigned x[16], y[16];
#pragma unroll
    for (int i = 0; i < 16; ++i) { auto rr = __builtin_amdgcn_permlane32_swap(a[i], a[i], false, false); x[i] = rr[0]; y[i] = rr[1]; }
    merge16(x, y);
#pragma unroll
    for (int i = 0; i < 16; ++i) a[i] = x[i];
}
struct PairTab { int pi[64], pj[64], n; };
constexpr PairTab make_pairs() { PairTab t{}; int n = 0; for (int i = 0; i < 16; ++i) for (int j = 0; j < 16; ++j) if ((i + 1) * (j + 1) <= 16) { t.pi[n] = i; t.pj[n] = j; ++n; } t.n = n; for (int k = n; k < 64; ++k) { t.pi[k] = 0; t.pj[k] = 0; } return t; }
constexpr PairTab PAIRS = make_pairs();
static_assert(PAIRS.n == 50, "candidate pairs");
constexpr int KEY_PITCH = 272;
constexpr int LDS_KEYS = 0, LDS_LKP = 2 * NKEYS * KEY_PITCH;
__device__ __forceinline__ void score_half_top16(Frame& F, const bf16* qfrag  , int half, int q32, int hi, unsigned (&top)[16]) {
    bf16x8 qf[8];
#pragma unroll
    for (int ks = 0; ks < 8; ++ks) qf[ks] = __builtin_nontemporal_load((const bf16x8*)(qfrag + ks * 512));
    unsigned cur[16];
#pragma unroll
    for (int tl = 0; tl < 4; ++tl) {
        f32x16 S = {};
        const LAS unsigned char* kp = F.lds + LDS_KEYS + (half * NKEYS + tl * 32 + q32) * KEY_PITCH + hi * 16;
#pragma unroll
        for (int ks = 0; ks < 8; ++ks) { const bf16x8 kf = *(const LAS bf16x8*)(kp + ks * 32); S = __builtin_amdgcn_mfma_f32_32x32x16_bf16(kf, qf[ks], S, 0, 0, 0); }
        unsigned a[16];
#pragma unroll
        for (int r = 0; r < 16; ++r) a[r] = (f2sortable(S[r]) & ~127u) | (unsigned)(tl * 32 + crow(r, hi));
        sort16(a);
        if (tl == 0) {
#pragma unroll
            for (int i = 0; i < 16; ++i) cur[i] = a[i];
        } else merge16(cur, a);
    }
    merge_halves(cur);
#pragma unroll
    for (int i = 0; i < 16; ++i) top[i] = cur[i];
}
__device__ __forceinline__ void topk_phase(Frame& F) {
    const int lane = F.lane, q32 = lane & 31, hi = lane >> 5;
    LAS unsigned* lkp = (LAS unsigned*)(F.lds + LDS_LKP + F.wave * 2048) + lane * 8;
    LAS unsigned char* lkpb = (LAS unsigned char*)lkp;
    constexpr int TOKB = 1024, NUNIT = (M / TOKB) * PEER_H;
    for (int unit = F.vcu; unit < NUNIT; unit += F.G) {
        const int h = unit & 7, sb = unit >> 3;
        __syncthreads();
        for (int ch = F.tid; ch < 2 * NKEYS * 16; ch += NWAVES * 64) {
            const int hf = ch >> 11, key = (ch >> 4) & 127, cc = ch & 15;
            const v4u v = *(const GAS v4u*)(F.KEYSB + ((size_t)(hf * PEER_H + h) * NKEYS + key) * DHALF + cc * 8);
            *(LAS v4u*)(F.lds + LDS_KEYS + (hf * NKEYS + key) * KEY_PITCH + cc * 16) = v;
        }
        __syncthreads();
        for (int blk = 0; blk < TOKB / 32 / NWAVES; ++blk) {
            const int tok = sb * TOKB + (blk * NWAVES + F.wave) * 32 + q32;
            const bf16* qfrag = F.QP + ((((size_t)(tok >> 5) * PEER_H + h) * 2) * 16 * 32 + hi * 32 + q32) * 8;
            unsigned t1[16], t2[16];
            score_half_top16(F, qfrag, 0, q32, hi, t1);
            score_half_top16(F, qfrag + 16 * 32 * 8, 1, q32, hi, t2);
#pragma unroll
            for (int i = 0; i < 4; ++i) {
                lkp[i] = (t1[4 * i] & 127u) | ((t1[4 * i + 1] & 127u) << 8) | ((t1[4 * i + 2] & 127u) << 16) | ((t1[4 * i + 3] & 127u) << 24);
                lkp[4 + i] = (t2[4 * i] & 127u) | ((t2[4 * i + 1] & 127u) << 8) | ((t2[4 * i + 2] & 127u) << 16) | ((t2[4 * i + 3] & 127u) << 24);
            }
            float v1[16], v2[16];
#pragma unroll
            for (int i = 0; i < 16; ++i) { v1[i] = sortable2f(t1[i] & ~127u); v2[i] = sortable2f(t2[i] & ~127u); }
            unsigned best[16];
#pragma unroll
            for (int g = 0; g < 4; ++g) {
                unsigned cnd[16];
#pragma unroll
                for (int e = 0; e < 16; ++e) { const int k = g * 16 + e;
                    if (k < PAIRS.n) cnd[e] = (f2sortable(v1[PAIRS.pi[k]] + v2[PAIRS.pj[k]]) & ~255u) | (unsigned)(PAIRS.pi[k] * 16 + (15 - PAIRS.pj[k])); else cnd[e] = 0u; }
                if (g != 0) sort16(cnd);
                if (g == 0) {
#pragma unroll
                    for (int i = 0; i < 16; ++i) best[i] = cnd[i];
                } else merge16(best, cnd);
            }
            LDS_WAIT();
            float bv[16]; int ex[16];
#pragma unroll
            for (int k = 0; k < 16; ++k) { const unsigned code = best[k] & 255u; bv[k] = sortable2f(best[k] & ~255u);
                const int i1 = lkpb[code >> 4], i2 = lkpb[16 + (15u - (code & 15u))]; ex[k] = i1 * NKEYS + i2; }
            float ssum = 0.f; const float bmax = bv[0];
#pragma unroll
            for (int k = 0; k < 16; ++k) { bv[k] = __expf(bv[k] - bmax); ssum += bv[k]; }
            const float rs = 1.0f / ssum;
            const size_t o = ((size_t)tok * PEER_H + h) * TOPK;
            if (hi == 0) {
#pragma unroll
                for (int k4 = 0; k4 < 4; ++k4) { v4u w;
#pragma unroll
                    for (int i = 0; i < 4; ++i) w[i] = (unsigned)ex[4 * k4 + i] | (cvtpk(0.f, bv[4 * k4 + i] * rs) & 0xffff0000u);
                    *(GAS v4u*)(F.IG + o + 4 * k4) = w; }
            }
            LDS_WAIT();
        }
    }
}

__device__ __forceinline__ float gelu_tanh(float x) {
    const float y = 0.7978845608028654f * (x + 0.044715f * x * x * x);
    const float e = __expf(2.0f * y);
    const float th = 1.0f - 2.0f / (1.0f + e);
    return 0.5f * x * (1.0f + th);
}
__device__ __forceinline__ void store_u32_uncounted(unsigned* p, unsigned v) { asm volatile("global_store_dword %0, %1, off" :: "v"(p), "v"(v) : "memory"); }
__device__ __forceinline__ void store_f32x2_uncounted(float* p, f32x2_t v) { asm volatile("global_store_dwordx2 %0, %1, off" :: "v"(p), "v"(v) : "memory"); }
template <int CTRL> __device__ __forceinline__ int dppi(int v) { return __builtin_amdgcn_update_dpp(0, v, CTRL, 0xf, 0xf, false); }
constexpr int DPP_ROR8 = 0x128, DPP_HMIRROR = 0x141, DPP_QX2 = 0x4e, DPP_QX1 = 0xb1;
template <int XM> __device__ __forceinline__ int swzx(int v) { return __builtin_amdgcn_ds_swizzle(v, 0x1f | (XM << 10)); }
template <int XM> __device__ __forceinline__ float swzxf(float v) { return __int_as_float(__builtin_amdgcn_ds_swizzle(__float_as_int(v), 0x1f | (XM << 10))); }
__device__ __forceinline__ void xq_phase(Frame& F) {
    const int gw = F.vcu * NWAVES + F.wave, NGW = F.G * NWAVES, lane = F.lane;
    if (gw >= M) return;
    float g2[16];
#pragma unroll
    for (int i = 0; i < 8; ++i) { g2[i] = F.ffn_g[8 * lane + i]; g2[8 + i] = F.ffn_g[512 + 8 * lane + i]; }
    float ssn = F.SSQ1[gw]; v4u wan = *(const GAS v4u*)(F.X1B + (size_t)gw * D + 8 * lane), wbn = *(const GAS v4u*)(F.X1B + (size_t)gw * D + 512 + 8 * lane);
    for (int tok = gw; tok < M; tok += NGW) {
        const float rinv1 = rsqrtf(ssn * (1.f / D) + EPS);
        const v4u wa = wan, wb = wbn;
        { const int tn = tok + NGW < M ? tok + NGW : tok; ssn = F.SSQ1[tn]; wan = *(const GAS v4u*)(F.X1B + (size_t)tn * D + 8 * lane); wbn = *(const GAS v4u*)(F.X1B + (size_t)tn * D + 512 + 8 * lane); }
        float xv[16];
#pragma unroll
        for (int i = 0; i < 4; ++i) { xv[2 * i] = bf_lo(wa[i]) * rinv1 * g2[2 * i]; xv[2 * i + 1] = bf_hi(wa[i]) * rinv1 * g2[2 * i + 1]; xv[8 + 2 * i] = bf_lo(wb[i]) * rinv1 * g2[8 + 2 * i]; xv[8 + 2 * i + 1] = bf_hi(wb[i]) * rinv1 * g2[8 + 2 * i + 1]; }
        float am = 0.f;
#pragma unroll
        for (int i = 0; i < 16; ++i) am = __builtin_fmaxf(am, __builtin_fabsf(xv[i]));
        am = wave_max(am);
        const float inv = am > 0.f ? 127.f / am : 0.f;
        v4u o;
#pragma unroll
        for (int j = 0; j < 4; ++j) { const int q0 = (int)__builtin_rintf(xv[4 * j] * inv), q1 = (int)__builtin_rintf(xv[4 * j + 1] * inv), q2 = (int)__builtin_rintf(xv[4 * j + 2] * inv), q3 = (int)__builtin_rintf(xv[4 * j + 3] * inv);
            o[j] = (unsigned)(q0 & 255) | ((unsigned)(q1 & 255) << 8) | ((unsigned)(q2 & 255) << 16) | ((unsigned)(q3 & 255) << 24); }
        { v2u oa; oa.x = o[0]; oa.y = o[1]; v2u ob; ob.x = o[2]; ob.y = o[3];
          *(GAS v2u*)(F.XQ + (size_t)tok * D + 8 * lane) = oa; *(GAS v2u*)(F.XQ + (size_t)tok * D + 512 + 8 * lane) = ob; }
        if (lane == 0) F.XS[tok] = am * (1.f / 127.f);
    }
}
struct PeerMap { int slice, rank, nper; };
__device__ __forceinline__ PeerMap peer_map(Frame& F, const XcdBarrier& bar) {
    unsigned sum = 0u, mine = 0u; bool ok = true;
#pragma unroll
    for (unsigned j = 0; j < 8; ++j) { const unsigned c = xb_ld(&bar.bar[XB_XCNT(j)]); sum += c; ok = ok && (c > 0u); mine = (j == bar.x) ? c : mine; }
    ok = ok && (sum == (unsigned)F.G) && (bar.x < 8u);
    PeerMap pm;
    if (ok) { pm.slice = (int)bar.x; pm.rank = (int)F.MISC[10]; pm.nper = (int)mine; }
    else { pm.nper = F.G >> 3; pm.slice = F.vcu / pm.nper; pm.rank = F.vcu % pm.nper; }
    return pm;
}
template <int VAR> __device__ __forceinline__ void u2_issue16(__amdgpu_buffer_rsrc_t urs, unsigned e10, int pass, int n, unsigned lane16, v4u (&rw)[16]) {
    const int nv = n - 16 * pass;
#pragma unroll
    for (int g = 0; g < 4; ++g) {
        if (g == 0 || 4 * g < nv) {
#pragma unroll
            for (int jj = 0; jj < 4; ++jj) { const int j = 4 * g + jj;
                const unsigned ro = (unsigned)__builtin_amdgcn_readlane((int)e10, 16 * pass + j);
                rw[j] = __builtin_bit_cast(v4u, __builtin_amdgcn_raw_buffer_load_b128(urs, (int)((VAR == 1 ? (ro & 0x7fe0fc00u) : ro) + lane16), 0, 0)); }
        }
    }
}
__device__ __forceinline__ int u2_dot16(const v4u (&rw)[16], const v4u xq, int lane) {
    const bool b3 = (lane & 8) != 0, b2 = (lane & 4) != 0, b1 = (lane & 2) != 0, b0 = (lane & 1) != 0;
    const int qx0 = (int)xq.x, qx1 = (int)xq.y, qx2 = (int)xq.z, qx3 = (int)xq.w;
    int p[16];
#pragma unroll
    for (int j = 0; j < 16; ++j) { const v4u r = rw[j]; int a = __builtin_amdgcn_sdot4((int)r.x, qx0, 0, false); a = __builtin_amdgcn_sdot4((int)r.y, qx1, a, false);
        a = __builtin_amdgcn_sdot4((int)r.z, qx2, a, false); p[j] = __builtin_amdgcn_sdot4((int)r.w, qx3, a, false); }
    int a8[8];
#pragma unroll
    for (int j = 0; j < 8; ++j) a8[j] = (b3 ? p[j + 8] : p[j]) + dppi<DPP_ROR8>(b3 ? p[j] : p[j + 8]);
    int a4[4];
#pragma unroll
    for (int j = 0; j < 4; ++j) a4[j] = (b2 ? a8[j + 4] : a8[j]) + dppi<DPP_HMIRROR>(b2 ? a8[j] : a8[j + 4]);
    int a2[2];
#pragma unroll
    for (int j = 0; j < 2; ++j) a2[j] = (b1 ? a4[j + 2] : a4[j]) + dppi<DPP_QX2>(b1 ? a4[j] : a4[j + 2]);
    int q = (b0 ? a2[1] : a2[0]) + dppi<DPP_QX1>(b0 ? a2[0] : a2[1]);
    q += swzx<16>(q);
    { auto rr = __builtin_amdgcn_permlane32_swap((unsigned)q, (unsigned)q, false, false); q = (int)rr[0] + (int)rr[1]; }
    return q;
}
struct U2Tok { unsigned ent, e10, r0, r1; int n, start; v4u xq; float xs, xsr, su, sv; };
template <int VAR> __device__ __forceinline__ void peer_u_phase(Frame& F, const PeerMap pm) {
    unsigned* const Wd = VAR ? (unsigned*)F.MIX : F.WP;
    const int lane = F.lane, nper = pm.nper, slice = pm.slice, rank = pm.rank;
    const int wi = rank * NWAVES + F.wave, NW = nper * NWAVES;
    const unsigned dummy = (unsigned)(slice << 11), lane16 = 16u * (unsigned)lane;
    LAS unsigned char* const sulds = F.lds + RING_OFF;
    for (int i = F.tid; i < 2048; i += NWAVES * 64) *(LAS f32x2_t*)(sulds + 8 * i) = *(const GAS f32x2_t*)(F.SU + 2 * ((size_t)slice * 2048 + i));
    __syncthreads();
    if (wi >= M) return;
    const __amdgpu_buffer_rsrc_t urs = __builtin_amdgcn_make_buffer_rsrc((void*)F.UQ, (short)0, NEXP * D, 0x00020000);
#define UTOK(t) ((t) < M ? (t) : wi)
    LAS unsigned* const slots = (LAS unsigned*)(F.lds + RING_OFF + 16384 + F.wave * 1024);
#define ULOAD(T, t) do { T.r0 = F.IG[(size_t)(t) * NSEL + lane]; T.r1 = F.IG[(size_t)(t) * NSEL + 64 + lane]; T.xsr = F.XS[(t)]; \
        T.xq = *(const GAS v4u*)(F.XQ + (size_t)(t) * D + 16 * lane); } while (0)
#define UFIX(T, sl_) do { const int s0_ = (int)((T.r0 & 0xffffu) >> 11), s1_ = (int)((T.r1 & 0xffffu) >> 11); \
        const unsigned long long b0_ = __ballot(s0_ == slice), b1_ = __ballot(s1_ == slice); \
        const int n0_ = __builtin_popcountll(b0_); T.n = n0_ + __builtin_popcountll(b1_); \
        T.start = __builtin_popcountll(__ballot(s0_ < slice)) + __builtin_popcountll(__ballot(s1_ < slice)); \
        LAS unsigned* const q_ = slots + 128 * (sl_); \
        if (s0_ == slice) q_[__builtin_amdgcn_mbcnt_hi((unsigned)(b0_ >> 32), __builtin_amdgcn_mbcnt_lo((unsigned)b0_, 0u))] = T.r0; \
        if (s1_ == slice) q_[n0_ + (int)__builtin_amdgcn_mbcnt_hi((unsigned)(b1_ >> 32), __builtin_amdgcn_mbcnt_lo((unsigned)b1_, 0u))] = T.r1; \
        asm volatile("" ::: "memory"); T.ent = q_[lane]; T.xs = __uint_as_float((unsigned)__builtin_amdgcn_readfirstlane((int)__float_as_uint(T.xsr))); \
        if (lane >= T.n) T.ent = dummy; T.su = 0.f; T.sv = 0.f; if (lane < T.n) { const unsigned e_ = T.ent & 0x7ffu; const f32x2_t sc_ = *(const LAS f32x2_t*)(sulds + 8 * e_); T.su = sc_.x; T.sv = sc_.y; } \
        T.e10 = lane < T.n ? (T.ent & 0xffffu) << 10 : 0x7f000000u; } while (0)
    U2Tok C, N; int par = 0;
    v4u bufA[16], bufB[16];
    ULOAD(C, wi); UFIX(C, 0);
    u2_issue16<VAR>(urs, C.e10, 0, C.n, lane16, bufA);
    if (C.n > 16) u2_issue16<VAR>(urs, C.e10, 1, C.n, lane16, bufB);
    for (int tok = wi; tok < M; tok += NW) {
        const int tn = UTOK(tok + NW);
        ULOAD(N, tn);
        int d = 0;
        { const int q = u2_dot16(bufA, C.xq, lane); d = (lane < 16) ? q : d; }
        par ^= 1; UFIX(N, par);
        u2_issue16<VAR>(urs, N.e10, 0, N.n, lane16, bufA);
        if (C.n > 16) {
            { const int q = u2_dot16(bufB, C.xq, lane); d = ((lane >> 4) == 1) ? q : d; }
            if (C.n > 32) { u2_issue16<VAR>(urs, C.e10, 2, C.n, lane16, bufB); const int q = u2_dot16(bufB, C.xq, lane); d = ((lane >> 4) == 2) ? q : d; }
            if (C.n > 48) { u2_issue16<VAR>(urs, C.e10, 3, C.n, lane16, bufB); const int q = u2_dot16(bufB, C.xq, lane); d = ((lane >> 4) == 3) ? q : d; }
        }
        if (lane < C.n) { const float act = C.su * C.xs * (float)d; const float g = __uint_as_float(C.ent & 0xffff0000u);
            store_u32_uncounted(Wd + (size_t)tok * NSEL + C.start + lane, ((unsigned)__builtin_bit_cast(unsigned short, (_Float16)(256.f * g * gelu_tanh(act) * C.sv)) << 16) | (C.ent & 0xffffu)); }
        for (int c0 = 64; c0 < C.n; c0 += 64) {
            const int nn = C.n - c0;
            unsigned ent = slots[128 * (par ^ 1) + c0 + (lane < nn ? lane : 0)]; if (lane >= nn) ent = dummy;
            float su = 0.f, sv = 0.f; if (lane < nn) { const f32x2_t sc_ = *(const LAS f32x2_t*)(sulds + 8 * (ent & 0x7ffu)); su = sc_.x; sv = sc_.y; }
            int d2 = 0;
            for (int ps = 0; ps < 4; ++ps) { if (16 * ps < nn) {
#pragma unroll
                for (int j = 0; j < 16; ++j) { const unsigned e = (unsigned)__builtin_amdgcn_readlane((int)ent, (16 * ps + j) & 63) & 0xffffu; const unsigned loff = (16 * ps + j < nn) ? lane16 : 0u;
                    bufB[j] = *(const GAS v4u*)(F.UQ + ((size_t)e << 10) + loff); }
                const int q = u2_dot16(bufB, C.xq, lane); d2 = ((lane >> 4) == ps) ? q : d2; } }
            if (lane < nn) { const float act = su * C.xs * (float)d2; const float g = __uint_as_float(ent & 0xffff0000u);
                Wd[(size_t)tok * NSEL + C.start + c0 + lane] = ((unsigned)__builtin_bit_cast(unsigned short, (_Float16)(256.f * g * gelu_tanh(act) * sv)) << 16) | (ent & 0xffffu); }
        }
        if (N.n > 16) u2_issue16<VAR>(urs, N.e10, 1, N.n, lane16, bufB);
        C = N;
    }
#undef UTOK
#undef ULOAD
#undef UFIX
}
template <int VAR> __device__ __forceinline__ void v_load_rows(const unsigned char* vq, const v4u (&m)[4], v4u (&r)[16]) {
#pragma unroll
    for (int j = 0; j < 16; ++j) r[j] = *(const GAS v4u*)(vq + (size_t)(m[j >> 2][j & 3] & (VAR == 1 ? 0x3ffu : 0xffffu)) * 128);
}
__device__ __forceinline__ void v_mix_store(const v4u (&r)[16], const v4u (&m)[4], const unsigned x1b, unsigned* xo, bool valid, bool b4, bool b3) {
    f32x2_t x1; x1.x = bf_lo(x1b); x1.y = bf_hi(x1b);
    h2_t acc[8];
#pragma unroll
    for (int i = 0; i < 8; ++i) acc[i] = (h2_t){(_Float16)0.f, (_Float16)0.f};
#pragma unroll
    for (int j = 0; j < 16; ++j) { const unsigned mw = m[j >> 2][j & 3]; const h2_t wpair = __builtin_bit_cast(h2_t, mw); const h2_t w2 = {wpair.y, wpair.y};
#pragma unroll
        for (int k = 0; k < 4; ++k) { const unsigned u = r[j][k];
            const h2_t c0 = __builtin_bit_cast(h2_t, __builtin_amdgcn_cvt_scalef32_pk_f16_fp8(u, 0.00390625f, false)), c1 = __builtin_bit_cast(h2_t, __builtin_amdgcn_cvt_scalef32_pk_f16_fp8(u, 0.00390625f, true));
            acc[2 * k] = __builtin_elementwise_fma(w2, c0, acc[2 * k]);
            acc[2 * k + 1] = __builtin_elementwise_fma(w2, c1, acc[2 * k + 1]); } }
    float t8[8];
#pragma unroll
    for (int i = 0; i < 8; ++i) { const float a = (i & 1) ? (float)acc[i >> 1].y : (float)acc[i >> 1].x, b = (i & 1) ? (float)acc[4 + (i >> 1)].y : (float)acc[4 + (i >> 1)].x;
        auto rr = __builtin_amdgcn_permlane32_swap(__float_as_uint(a), __float_as_uint(b), false, false); t8[i] = __uint_as_float(rr[0]) + __uint_as_float(rr[1]); }
    float t4[4];
#pragma unroll
    for (int i = 0; i < 4; ++i) t4[i] = (b4 ? t8[i + 4] : t8[i]) + swzxf<16>(b4 ? t8[i] : t8[i + 4]);
    float t2[2];
#pragma unroll
    for (int i = 0; i < 2; ++i) t2[i] = (b3 ? t4[i + 2] : t4[i]) + swzxf<8>(b3 ? t4[i] : t4[i + 2]);
    f32x2_t x2; x2.x = x1.x + t2[0]; x2.y = x1.y + t2[1];
    if (valid) store_u32_uncounted(xo, cvtpk(x2.x, x2.y));
}
template <int VAR> __device__ __forceinline__ void peer_v_phase(Frame& F, const PeerMap pm) {
    const int lane = F.lane, nper = pm.nper, slice = pm.slice, rank = pm.rank;
    const int wi = rank * NWAVES + F.wave, NW = nper * NWAVES, rg = lane >> 3, ch = lane & 7;
    const bool b4 = (lane & 16) != 0, b3 = (lane & 8) != 0;
    const unsigned char* vq = F.VQ + (size_t)slice * NEXP * 128 + 16 * ch;
    const int col = slice * 128 + 16 * ch + 2 * rg;
    if (wi >= M) return;
    float* const dummy = (float*)((unsigned char*)F.MIX + 16 * MiB);
#define VTOK(t) ((t) < M ? (t) : wi)
    v4u m0[4], m1[4], rA[16], rB[16]; unsigned xA, xB; v2u mg;
    LAS unsigned* mlds = (LAS unsigned*)(F.lds + RING_OFF + F.wave * 2048);
#define VX1(t) (*(const GAS unsigned*)(F.X1B + (size_t)(t) * D + col))
#define VOUT(t) ((unsigned*)(VAR ? (bf16*)dummy + (size_t)((t) & 1023) * D + col : F.X2B + (size_t)(t) * D + col))
#define VMG(t) (*(const GAS v2u*)(F.WP + (size_t)(t) * NSEL + 2 * lane))
#define VMPUT(slot, v) (*(LAS v2u*)(mlds + (slot) * 128 + 2 * lane) = (v))
#define VMGET(slot, m) do { _Pragma("unroll") for (int i_ = 0; i_ < 4; ++i_) m[i_] = *(const LAS v4u*)(mlds + (slot) * 128 + 16 * rg + 4 * i_); } while (0)
    mg = VMG(wi); VMPUT(0, mg); VMGET(0, m0);
    mg = VMG(VTOK(wi + NW)); VMPUT(1, mg); VMGET(1, m1);
    xA = VX1(wi);
    v_load_rows<VAR>(vq, m0, rA);
    mg = VMG(VTOK(wi + 2 * NW));
    for (int tok = wi; tok < M; tok += 2 * NW) {
        xB = VX1(VTOK(tok + NW));
        v_load_rows<VAR>(vq, m1, rB);
        VMPUT(0, mg);
        mg = VMG(VTOK(tok + 3 * NW));
        __builtin_amdgcn_sched_barrier(0);
        v_mix_store(rA, m0, xA, VOUT(tok), true, b4, b3);
        VMGET(0, m0);
        __builtin_amdgcn_sched_barrier(0);
        xA = VX1(VTOK(tok + 2 * NW));
        v_load_rows<VAR>(vq, m0, rA);
        VMPUT(1, mg);
        mg = VMG(VTOK(tok + 4 * NW));
        __builtin_amdgcn_sched_barrier(0);
        v_mix_store(rB, m1, xB, VOUT(VTOK(tok + NW)), tok + NW < M, b4, b3);
        VMGET(1, m1);
        __builtin_amdgcn_sched_barrier(0);
    }
#undef VMG
#undef VMPUT
#undef VMGET
#undef VX1
#undef VOUT
#undef VTOK
}
__device__ __forceinline__ void final_phase(Frame& F) {
    const int gw = F.vcu * NWAVES + F.wave, NGW = F.G * NWAVES;
    const int lane = F.lane;
    const GAS f32x4* gr = (const GAS f32x4*)F.fin_g + lane;
    f32x4 gg[4];
#pragma unroll
    for (int j = 0; j < 4; ++j) gg[j] = gr[64 * j];
    for (int m = gw; m < M; m += 2 * NGW) {
        const bool ok1 = m + NGW < M; const int m1 = ok1 ? m + NGW : m;
        const GAS unsigned long long* a0 = (const GAS unsigned long long*)(F.X2B + (size_t)m * D) + lane; const GAS unsigned long long* a1 = (const GAS unsigned long long*)(F.X2B + (size_t)m1 * D) + lane;
        unsigned long long u[4], w[4];
#pragma unroll
        for (int j = 0; j < 4; ++j) { u[j] = a0[64 * j]; w[j] = a1[64 * j]; }
        f32x4 v[4], z[4]; float s = 0.f, t = 0.f;
#pragma unroll
        for (int j = 0; j < 4; ++j) { v[j].x = bf_lo((unsigned)u[j]); v[j].y = bf_hi((unsigned)u[j]); v[j].z = bf_lo((unsigned)(u[j] >> 32)); v[j].w = bf_hi((unsigned)(u[j] >> 32));
            z[j].x = bf_lo((unsigned)w[j]); z[j].y = bf_hi((unsigned)w[j]); z[j].z = bf_lo((unsigned)(w[j] >> 32)); z[j].w = bf_hi((unsigned)(w[j] >> 32));
            s += (v[j].x * v[j].x + v[j].y * v[j].y) + (v[j].z * v[j].z + v[j].w * v[j].w); t += (z[j].x * z[j].x + z[j].y * z[j].y) + (z[j].z * z[j].z + z[j].w * z[j].w); }
        const float r0 = rsqrtf(wave_sum(s) * (1.f / D) + EPS), r1 = rsqrtf(wave_sum(t) * (1.f / D) + EPS);
        GAS f32x4* o0 = (GAS f32x4*)(F.out + (size_t)m * D) + lane; GAS f32x4* o1 = (GAS f32x4*)(F.out + (size_t)m1 * D) + lane;
#pragma unroll
        for (int j = 0; j < 4; ++j) { f32x4 o; o.x = v[j].x * r0 * gg[j].x; o.y = v[j].y * r0 * gg[j].y; o.z = v[j].z * r0 * gg[j].z; o.w = v[j].w * r0 * gg[j].w; __builtin_nontemporal_store(o, o0 + 64 * j);
            if (ok1) { f32x4 p; p.x = z[j].x * r1 * gg[j].x; p.y = z[j].y * r1 * gg[j].y; p.z = z[j].z * r1 * gg[j].z; p.w = z[j].w * r1 * gg[j].w; __builtin_nontemporal_store(p, o1 + 64 * j); } }
    }
}

struct Args { const float* in[14]; float* out; unsigned char* ws; int ph_lo, ph_hi, li, pad; };
__global__ void __launch_bounds__(NWAVES * 64, 2) mk_fwd(Args args) {
    extern __shared__ __attribute__((aligned(16))) unsigned char lds[];
    Frame F;
    F.lds = (LAS unsigned char*)lds;
    F.MISC = (volatile LAS unsigned*)(F.lds + MISC_OFF);
    F.tid = threadIdx.x; F.lane = F.tid & 63; F.wave = __builtin_amdgcn_readfirstlane(F.tid >> 6);
    F.G = gridDim.x; { const int bx = blockIdx.x; F.vcu = (F.G % 8 == 0) ? (bx % 8) * (F.G / 8) + bx / 8 : bx; }
#define GRID_BAR(seam) do { if (N_LAUNCHES == PER_PHASE) { if (F.tid == 0) __hip_atomic_store(F.ctl + CW_TMO, 0xBADBA0u | (unsigned)(seam), RLX_AGENT); } \
    else { xcd_barrier(bar); } } while (0)
    unsigned char* ws = args.ws;
    F.ctl = (gu32*)(ws + WS_CTL);
    F.x = args.in[0]; F.mix_g = args.in[1]; F.w_in = args.in[2]; F.conv_w = args.in[3]; F.conv_b = args.in[4]; F.attn_g = args.in[5]; F.conv_g = args.in[6];
    F.w_out = args.in[7]; F.ffn_g = args.in[8]; F.wq = args.in[9]; F.keys = args.in[10]; F.pu = args.in[11]; F.pv = args.in[12]; F.fin_g = args.in[13];
    F.out = args.out;
    F.WinT = (bf16*)(ws + WS_WIN); F.WoutT = (bf16*)(ws + WS_WOUT); F.WqT = (bf16*)(ws + WS_WQ); F.KEYSB = (bf16*)(ws + WS_KEYS);
    F.UQ = ws + WS_UQ; F.VQ = ws + WS_VQ; F.SU = (float*)(ws + WS_SU); F.SV = (float*)(ws + WS_SV); F.XQ = ws + WS_XQ; F.X2B = (bf16*)(ws + WS_XN); F.X1B = (bf16*)(ws + WS_X1B); F.XS = (float*)(ws + WS_XS); F.XN = (bf16*)(ws + WS_XN);
    F.Q = (bf16*)(ws + WS_Q); F.K = F.Q + (size_t)M * HW; F.GB = F.K + (size_t)M * HW; F.UU = F.GB + (size_t)M * HW;
    F.VTR = (bf16*)(ws + WS_VTR); F.QP = (bf16*)(ws + WS_QP); F.MIX = (bf16*)(ws + WS_MIX);
    F.SSQ1 = (float*)(ws + WS_SSQ1); F.IG = (unsigned*)(ws + WS_IDX); F.IGS = (unsigned*)(ws + WS_GW); F.PFX = (unsigned*)(ws + WS_PFX); F.WP = (unsigned*)(ws + WS_W);
    for (int u = F.tid; u < (LDS_BYTES - LDSCTL_OFF) / 4; u += NWAVES * 64) ((LAS unsigned*)(F.lds + LDSCTL_OFF))[u] = 0u;
    __syncthreads();
    XcdBarrier bar; bar.bar = (unsigned*)(F.ctl + CW_BAR); bar.x = 0; bar.st = nullptr;
    if (N_LAUNCHES != PER_PHASE) { bar = xcd_barrier_post((unsigned*)(F.ctl + CW_BAR), F.MISC + 8);
        if (F.tid == 0) F.MISC[10] = __hip_atomic_fetch_add(F.ctl + CW_TICKET + 64 * bar.x, 1u, RLX_AGENT); }
    const int lo = args.ph_lo, hi = args.ph_hi;
#define IN(k) (lo <= (k) && (k) < hi)
#define REFRESH() do { int t_ = threadIdx.x; asm volatile("" : "+v"(t_)); F.tid = t_; F.lane = t_ & 63; F.wave = __builtin_amdgcn_readfirstlane(t_ >> 6); } while (0)
#ifndef MK_REP_PHASE
#define MK_REP_PHASE -1
#endif
#define REPS(k) ((k) == MK_REP_PHASE ? 2 : 1)


#define BOTH(k) (IN(k) && IN((k) + 1))

    if (IN(0)) { REFRESH(); for (int rep = 0; rep < REPS(0); ++rep) { p0_prologue<0>(F, F.vcu * NWAVES + F.wave, F.G * NWAVES); if (rep + 1 < REPS(0)) GRID_BAR(0); } if (BOTH(0)) GRID_BAR(0); }

    if (IN(1)) { for (int rep = 0; rep < REPS(1); ++rep) {
        { pg8::Gemm g{F.XN, F.WinT, M, 5 * HW, D}; pg8::StaticOrder S; S.init(M, 5 * HW, F.G, (int)blockIdx.x);
          pg8::EpiProj E{F.Q, (size_t)M * HW, QSCALE};
          pg8::gemm_phase<pg8::EpiProj, pg8::StaticOrder, PG8_ALIGN, PG8_SP2>(F.lds + RING_OFF, g, S, E); }
        { pg8::Gemm g{F.WinT + (size_t)5 * HW * D, F.XN, HW, M, D}; pg8::StaticOrder S; S.init(HW, M, F.G, (int)blockIdx.x);
          pg8::EpiVT E{F.VTR};
          pg8::gemm_phase<pg8::EpiVT, pg8::StaticOrder, PG8_ALIGN, PG8_SP2>(F.lds + RING_OFF, g, S, E); }
        if (rep + 1 < REPS(1)) GRID_BAR(1); }
        if (BOTH(1)) GRID_BAR(1);
    }

    if (IN(2)) { REFRESH(); for (int rep = 0; rep < REPS(2); ++rep) {
        if (F.tid == 0) *(volatile LAS unsigned*)(F.lds + RING_OFF + 2048) = 0u;
        __syncthreads();
        if (F.wave < ATT_WAVES) { attn_phase(F); p0_quant_rows(F, F.vcu * ATT_WAVES + F.wave, F.G * ATT_WAVES, Q_SPLIT, 2 * NEXP); }
        else { const int sgw = F.vcu * (NWAVES - ATT_WAVES) + (F.wave - ATT_WAVES), SNGW = F.G * (NWAVES - ATT_WAVES); conv_phase(F, sgw, SNGW); p0_prologue<1>(F, sgw, SNGW); }
        if (rep + 1 < REPS(2)) GRID_BAR(2); } if (BOTH(2)) GRID_BAR(2); }

    if (IN(3)) {
        pg8::Gemm g{F.MIX, F.WoutT, M, D, D}; pg8::StaticOrder S; S.init(M, D, F.G, (int)blockIdx.x);
        pg8::EpiResid E{F.x, F.X1B, F.SSQ1, D};
        pg8::gemm_phase<pg8::EpiResid, pg8::StaticOrder, PG8_ALIGN, PG8_SP2>(F.lds + RING_OFF, g, S, E);
        if (BOTH(3)) GRID_BAR(3);
    }

    if (IN(4)) {
        pg8::Gemm g{F.X1B, F.WqT, M, PEER_H * PEER_DK, D}; pg8::StaticOrder S; S.init(M, PEER_H * PEER_DK, F.G, (int)blockIdx.x);
        pg8::EpiBf16Rs E{F.QP, PEER_H * PEER_DK, F.SSQ1, 1.f / D, EPS};
        pg8::gemm_phase<pg8::EpiBf16Rs, pg8::StaticOrder, PG8_ALIGN, PG8_SP2>(F.lds + RING_OFF, g, S, E);
#ifdef MK_GEMM4X2
        GRID_BAR(4); pg8::gemm_phase<pg8::EpiBf16Rs, pg8::StaticOrder, PG8_ALIGN, PG8_SP2>(F.lds + RING_OFF, g, S, E);
#endif
        if (BOTH(4)) GRID_BAR(4);
    }

    if (IN(5)) { REFRESH(); for (int rep = 0; rep < REPS(5); ++rep) { topk_phase(F); xq_phase(F); if (rep + 1 < REPS(5)) GRID_BAR(5); } if (BOTH(5)) GRID_BAR(5); }


    if (IN(7)) { REFRESH(); peer_u_phase<0>(F, peer_map(F, bar));
#ifdef MK_UVAR
        GRID_BAR(7); peer_u_phase<MK_UVAR>(F, peer_map(F, bar));
#endif
        if (BOTH(7)) GRID_BAR(7); }

    if (IN(8)) { REFRESH();
#ifdef MK_VVAR
        peer_v_phase<MK_VVAR>(F, peer_map(F, bar)); GRID_BAR(8);
#endif
        peer_v_phase<0>(F, peer_map(F, bar)); if (BOTH(8)) GRID_BAR(8); }

    if (IN(9)) { REFRESH(); final_phase(F); }
#undef IN
#undef BOTH
}

extern "C" void kernel_launch(void* const* d_in, const int* in_sizes, int n_in, void* d_out, int out_size, void* d_ws, size_t ws_size, hipStream_t stream) {
    static int grid = 0;
    if (grid == 0) {
        if (n_in != 14 || in_sizes[0] != M * D || out_size != M * D || ws_size < WS_END) { fprintf(stderr, "kernel_launch: unexpected shapes: n_in %d in0 %d out %d ws %zu\n", n_in, n_in > 0 ? in_sizes[0] : -1, out_size, ws_size); grid = -1; return; }
        int dev = 0, cus = 0, per_cu = 0;
        if (hipGetDevice(&dev) != hipSuccess || hipDeviceGetAttribute(&cus, hipDeviceAttributeMultiprocessorCount, dev) != hipSuccess) { grid = -1; return; }
        if (hipFuncSetAttribute((const void*)mk_fwd, hipFuncAttributeMaxDynamicSharedMemorySize, LDS_BYTES) != hipSuccess) { fprintf(stderr, "kernel_launch: hipFuncSetAttribute failed\n"); grid = -1; return; }
        if (hipOccupancyMaxActiveBlocksPerMultiprocessor(&per_cu, (const void*)mk_fwd, NWAVES * 64, LDS_BYTES) != hipSuccess || per_cu < 1)
            fprintf(stderr, "kernel_launch: note: occupancy query reports %d workgroups per CU\n", per_cu);
        (void)hipGetLastError();
        grid = cus;
    }
    if (grid < 0) return;
    if (hipMemsetAsync((char*)d_ws + WS_CTL, 0, CTL_ZERO_BYTES, stream) != hipSuccess) { fprintf(stderr, "kernel_launch: hipMemsetAsync failed\n"); return; }
    Args a{};
    for (int i = 0; i < 14; ++i) a.in[i] = (const float*)d_in[i];
    a.out = (float*)d_out; a.ws = (unsigned char*)d_ws;
    if (N_LAUNCHES == PER_PHASE) {
        for (int li = 0; li < PER_PHASE; ++li) { a.ph_lo = li; a.ph_hi = li + 1; a.li = li; hipLaunchKernelGGL(mk_fwd, dim3(grid), dim3(NWAVES * 64), LDS_BYTES, stream, a); }
    } else {
        a.ph_lo = 0; a.ph_hi = PER_PHASE; a.li = 0;
        hipLaunchKernelGGL(mk_fwd, dim3(grid), dim3(NWAVES * 64), LDS_BYTES, stream, a);
    }
    const hipError_t le = hipPeekAtLastError();
    if (le != hipSuccess) fprintf(stderr, "kernel_launch: launch failed: %s\n", hipGetErrorName(le));
}
```

```cpp
#include <hip/hip_runtime.h>
#include <cstdio>
#include <cstdint>
namespace pg8 {
#define PG8_LAS __attribute__((address_space(3)))
typedef unsigned short bf16_t;
typedef short bf16x8 __attribute__((ext_vector_type(8)));
typedef float f32x4 __attribute__((ext_vector_type(4)));
typedef unsigned u32x4 __attribute__((ext_vector_type(4)));
constexpr int BM = 256, BK = 64, HALF = 128, HTB = HALF * BK * 2  , STAGE_BYTES = 8 * HTB, NXCD = 8, WGM = 8;

__host__ __device__ __forceinline__ int lds_byte(int r, int c) { const int st = (r >> 4) * 2 + (c >> 5), rr = r & 15, cc = c & 31, ob = rr * 64 + cc * 2; return st * 1024 + (ob ^ (((ob >> 9) & 1) << 5)); }
__host__ __device__ __forceinline__ void stage_rc(int b, int& R, int& C) { const int st = b / 1024, sb = b % 1024, swz = sb ^ (((sb >> 9) & 1) << 5); R = (st >> 1) * 16 + swz / 64; C = (st & 1) * 32 + (swz % 64) / 2; }
__host__ __device__ __forceinline__ int perm32(int rho) { const int n = rho >> 4, i = rho & 15; return 8 * (i >> 2) + 4 * n + (i & 3); }

struct Unit { int pm, pn; };
struct Gemm { const bf16_t* A; const bf16_t* Bt; int M, N, K; };

struct StaticOrder {
    int nM, nN, nwg, G, c;
    __host__ __device__ void init(int M, int N, int G_, int c_) { nM = M / BM; nN = N / BM; nwg = nM * nN; G = G_; c = c_; }
    __host__ __device__ bool next(int i, Unit& u) const {
        const long L = (long)i * G + c; if (L >= nwg) return false;
        int wgid = (int)L; { const int q = nwg / NXCD, r = nwg % NXCD, xcd = wgid % NXCD, off = wgid / NXCD; wgid = (xcd < r ? xcd * (q + 1) : r * (q + 1) + (xcd - r) * q) + off; }
        const int nig = WGM * nN, gid = wgid / nig, fm = gid * WGM, gsz = (nM - fm) < WGM ? (nM - fm) : WGM;
        u.pm = fm + ((wgid % nig) % gsz); u.pn = (wgid % nig) / gsz; return true;
    }
    __device__ __forceinline__ void a_ready(const Unit&) const {}
    __device__ __forceinline__ void done(const Unit&) const {}
};

__device__ __forceinline__ unsigned cvt_pk_bf16(float lo, float hi) { unsigned r; asm volatile("v_cvt_pk_bf16_f32 %0, %1, %2" : "=v"(r) : "v"(lo), "v"(hi)); return r; }
typedef float f32x2 __attribute__((ext_vector_type(2)));
__device__ __forceinline__ f32x2 gelu_pk(f32x2 v) {
    const f32x2 av = __builtin_elementwise_abs(v), d = av * 0.2316418882f + 1.0f;
    f32x2 t; t.x = __builtin_amdgcn_rcpf(d.x); t.y = __builtin_amdgcn_rcpf(d.y);
    f32x2 q = t * 0.5307027145f + (-0.7265760135f); q = q * t + 0.7107068705f; q = q * t + (-0.142248368f); q = q * t + 0.127414796f; q = q * t;
    const f32x2 s = (v * v) * (-0.72134752044f);
    f32x2 e; e.x = __builtin_amdgcn_exp2f(s.x); e.y = __builtin_amdgcn_exp2f(s.y);
    const f32x2 m = v * (q * e), r = v - m;
    f32x2 o; o.x = v.x < 0.f ? m.x : r.x; o.y = v.y < 0.f ? m.y : r.y; return o;
}

template <int ACT  > struct EpiBf16 {
    static constexpr bool PERM = true, AFTER_DRAIN = false; static_assert(ACT == 0 || ACT == 1, "EpiBf16: ACT is 0 (none) or 1 (gelu_pk)");
    bf16_t* O; int ldc; const float* bias; int split_cols; size_t split_stride; float scale0;
    __device__ __forceinline__ void operator()(const f32x4 (&acc)[2][2][4][2], const Unit& u, int wr, int wc, int fr, int fq) const {
        const int row0 = u.pm * BM + wr * 64 + fr; int colt = u.pn * BM; bf16_t* base = O;
        float sc = 1.f; if (split_cols) { const int t = colt / split_cols; base += (size_t)t * split_stride; colt -= t * split_cols; if (t == 0) sc = scale0; }
        const int col0 = colt + wc * 32 + 8 * fq, bcol0 = u.pn * BM + wc * 32 + 8 * fq;
        f32x4 bv[2][2];
#pragma unroll
        for (int bj = 0; bj < 2; ++bj)
#pragma unroll
            for (int n = 0; n < 2; ++n) bv[bj][n] = bias ? *(const f32x4*)(bias + bcol0 + bj * HALF + 4 * n) : (f32x4){0.f, 0.f, 0.f, 0.f};
#pragma unroll
        for (int ai = 0; ai < 2; ++ai)
#pragma unroll
            for (int m = 0; m < 4; ++m) { bf16_t* rowp = base + (size_t)(row0 + ai * HALF + m * 16) * ldc + col0;
#pragma unroll
                for (int bj = 0; bj < 2; ++bj) { f32x4 v0 = acc[ai][bj][m][0] + bv[bj][0], v1 = acc[ai][bj][m][1] + bv[bj][1];
                    if (ACT == 1) { f32x2 a = gelu_pk((f32x2){v0[0], v0[1]}), b = gelu_pk((f32x2){v0[2], v0[3]}), c = gelu_pk((f32x2){v1[0], v1[1]}), d = gelu_pk((f32x2){v1[2], v1[3]});
                        v0 = (f32x4){a.x, a.y, b.x, b.y}; v1 = (f32x4){c.x, c.y, d.x, d.y}; }
                    v0 = v0 * sc; v1 = v1 * sc; u32x4 w; w.x = cvt_pk_bf16(v0[0], v0[1]); w.y = cvt_pk_bf16(v0[2], v0[3]); w.z = cvt_pk_bf16(v1[0], v1[1]); w.w = cvt_pk_bf16(v1[2], v1[3]);
                    *(u32x4*)(rowp + bj * HALF) = w; } }
    }
};
typedef unsigned u32x2 __attribute__((ext_vector_type(2)));
struct EpiResid {
    static constexpr bool PERM = true, AFTER_DRAIN = false;
    const float* X; bf16_t* X1; float* ssq; int ldc;
    __device__ __forceinline__ void operator()(const f32x4 (&acc)[2][2][4][2], const Unit& u, int wr, int wc, int fr, int fq) const {
        const int row0 = u.pm * BM + wr * 64 + fr, col0 = u.pn * BM + wc * 32 + 8 * fq;
#pragma unroll
        for (int ai = 0; ai < 2; ++ai)
#pragma unroll
            for (int m = 0; m < 4; ++m) { const int row = row0 + ai * HALF + m * 16; const size_t off = (size_t)row * ldc + col0; float s = 0.f;
#pragma unroll
                for (int bj = 0; bj < 2; ++bj) { const f32x4 x0 = *(const f32x4*)(X + off + bj * HALF), x1 = *(const f32x4*)(X + off + bj * HALF + 4);
                    const f32x4 v0 = x0 + acc[ai][bj][m][0], v1 = x1 + acc[ai][bj][m][1];
                    u32x4 w; w.x = cvt_pk_bf16(v0[0], v0[1]); w.y = cvt_pk_bf16(v0[2], v0[3]); w.z = cvt_pk_bf16(v1[0], v1[1]); w.w = cvt_pk_bf16(v1[2], v1[3]);
                    *(u32x4*)(X1 + off + bj * HALF) = w;
                    s += ((v0[0] * v0[0] + v0[1] * v0[1]) + (v0[2] * v0[2] + v0[3] * v0[3])) + ((v1[0] * v1[0] + v1[1] * v1[1]) + (v1[2] * v1[2] + v1[3] * v1[3])); }
                s += __shfl_xor(s, 16); s += __shfl_xor(s, 32);
                if (fq == 0) __hip_atomic_fetch_add(ssq + row, s, __ATOMIC_RELAXED, __HIP_MEMORY_SCOPE_AGENT);
                asm volatile("" ::: "memory"); }
    }
};
struct EpiBf16Rs {
    static constexpr bool PERM = true, AFTER_DRAIN = false;
    bf16_t* O; int ldc; const float* ssq; float inv_n, eps;
    __device__ __forceinline__ void operator()(const f32x4 (&acc)[2][2][4][2], const Unit& u, int wr, int wc, int fr, int fq) const {
        const int row0 = u.pm * BM + wr * 64 + fr;
        const int ks = wc * 2 + (fq >> 1), hi = fq & 1;
#pragma unroll
        for (int ai = 0; ai < 2; ++ai)
#pragma unroll
            for (int m = 0; m < 4; ++m) { const int row = row0 + ai * HALF + m * 16; const float sc = rsqrtf(ssq[row] * inv_n + eps);
#pragma unroll
                for (int bj = 0; bj < 2; ++bj) { const f32x4 v0 = acc[ai][bj][m][0] * sc, v1 = acc[ai][bj][m][1] * sc;
                    u32x4 w; w.x = cvt_pk_bf16(v0[0], v0[1]); w.y = cvt_pk_bf16(v0[2], v0[3]); w.z = cvt_pk_bf16(v1[0], v1[1]); w.w = cvt_pk_bf16(v1[2], v1[3]);
                    const size_t blk = ((((size_t)(row >> 5) * 8 + u.pn) * 2 + bj) * 8 + ks) * 2 + hi;
                    __builtin_nontemporal_store(w, (u32x4*)(O + (blk * 32 + (row & 31)) * 8)); } }
    }
};
struct EpiProj {
    static constexpr bool PERM = true, AFTER_DRAIN = false;
    bf16_t* O; size_t stride; float scale0;
    __device__ __forceinline__ void operator()(const f32x4 (&acc)[2][2][4][2], const Unit& u, int wr, int wc, int fr, int fq) const {
        const int row0 = u.pm * BM + wr * 64 + fr;
        if (u.pn < 4) {
            const int t = u.pn >> 1; bf16_t* base = O + (size_t)t * stride; const float sc = t == 0 ? scale0 : 1.f;
#pragma unroll
            for (int bj = 0; bj < 2; ++bj) { const int col = (u.pn & 1) * BM + bj * HALF + wc * 32 + 8 * fq, head = col >> 6, ks = (col >> 4) & 3, hi = (col >> 3) & 1;
#pragma unroll
                for (int ai = 0; ai < 2; ++ai)
#pragma unroll
                    for (int m = 0; m < 4; ++m) { const int row = row0 + ai * HALF + m * 16; const f32x4 v0 = acc[ai][bj][m][0] * sc, v1 = acc[ai][bj][m][1] * sc;
                        u32x4 w; w.x = cvt_pk_bf16(v0[0], v0[1]); w.y = cvt_pk_bf16(v0[2], v0[3]); w.z = cvt_pk_bf16(v1[0], v1[1]); w.w = cvt_pk_bf16(v1[2], v1[3]);
                        { u32x4* dst_ = (u32x4*)(base + ((((((size_t)(row >> 5) * 8 + head) * 4 + ks) * 2 + hi) * 32 + (row & 31)) * 8)); if (t == 0) __builtin_nontemporal_store(w, dst_); else *dst_ = w; } } }
        } else if (u.pn < 6) {
            const int t = u.pn >> 1; bf16_t* base = O + (size_t)t * stride; const float sc = 1.f;
            const int col0 = (u.pn & 1) * BM + wc * 32 + 8 * fq;
#pragma unroll
            for (int ai = 0; ai < 2; ++ai)
#pragma unroll
                for (int m = 0; m < 4; ++m) { bf16_t* rowp = base + (size_t)(row0 + ai * HALF + m * 16) * 512 + col0;
#pragma unroll
                    for (int bj = 0; bj < 2; ++bj) { const f32x4 v0 = acc[ai][bj][m][0] * sc, v1 = acc[ai][bj][m][1] * sc;
                        u32x4 w; w.x = cvt_pk_bf16(v0[0], v0[1]); w.y = cvt_pk_bf16(v0[2], v0[3]); w.z = cvt_pk_bf16(v1[0], v1[1]); w.w = cvt_pk_bf16(v1[2], v1[3]);
                        *(u32x4*)(rowp + bj * HALF) = w; } }
        } else {
            bf16_t* base = O + 3 * stride; const int ch0 = (u.pn - 6) * HALF + wc * 32 + 8 * fq;
#pragma unroll
            for (int ai = 0; ai < 2; ++ai)
#pragma unroll
                for (int m = 0; m < 4; ++m) { const f32x4 v0 = acc[ai][0][m][0] * acc[ai][1][m][0], v1 = acc[ai][0][m][1] * acc[ai][1][m][1];
                    u32x4 w; w.x = cvt_pk_bf16(v0[0], v0[1]); w.y = cvt_pk_bf16(v0[2], v0[3]); w.z = cvt_pk_bf16(v1[0], v1[1]); w.w = cvt_pk_bf16(v1[2], v1[3]);
                    *(u32x4*)(base + (size_t)(row0 + ai * HALF + m * 16) * 512 + ch0) = w; }
        }
    }
};
struct EpiVT {
    static constexpr bool PERM = true, AFTER_DRAIN = false;
    bf16_t* O;
    __device__ __forceinline__ void operator()(const f32x4 (&acc)[2][2][4][2], const Unit& u, int wr, int wc, int fr, int fq) const {
        const int row0 = u.pm * BM + wr * 64 + fr;
#pragma unroll
        for (int bj = 0; bj < 2; ++bj) { const int tok0 = u.pn * BM + bj * HALF + wc * 32 + 8 * fq, tb = tok0 >> 5, s = (tok0 >> 4) & 1, ab = (tok0 >> 3) & 1;
#pragma unroll
            for (int ai = 0; ai < 2; ++ai)
#pragma unroll
                for (int m = 0; m < 4; ++m) { const int r = row0 + ai * HALF + m * 16, h = r >> 6, db = (r >> 5) & 1, d32 = r & 31;
                    const f32x4 v0 = acc[ai][bj][m][0], v1 = acc[ai][bj][m][1];
                    u32x2 lo, hi2; lo.x = cvt_pk_bf16(v0[0], v0[1]); lo.y = cvt_pk_bf16(v0[2], v0[3]); hi2.x = cvt_pk_bf16(v1[0], v1[1]); hi2.y = cvt_pk_bf16(v1[2], v1[3]);
                    bf16_t* p = O + (((((((size_t)tb * 8 + h) * 2 + db) * 2 + s) * 2 + ab) * 2) * 32 + d32) * 4;
                    *(u32x2*)p = lo; *(u32x2*)(p + 128) = hi2; } }
    }
};
template <class Epi, class Sched, bool ALIGN_EPI = false, bool SP2 = false>
__device__ __forceinline__ void gemm_phase(PG8_LAS unsigned char* lds, const Gemm g, const Sched& S, const Epi& E) {
    const int tid = threadIdx.x, wid = __builtin_amdgcn_readfirstlane(tid >> 6), lane = tid & 63, wr = wid >> 2, wc = wid & 3, fr = lane & 15, fq = lane >> 4;
    const int K = g.K, nt = K / BK;
    unsigned voffA[2], voffB[2];
#pragma unroll
    for (int i = 0; i < 2; ++i) { int R, C; stage_rc(tid * 16 + i * 8192, R, C); const int Rb = Epi::PERM ? ((R & ~31) + perm32(R & 31)) : R;
        voffA[i] = (unsigned)(R * K + C) * 2u; voffB[i] = (unsigned)(Rb * K + C) * 2u; }
    const size_t kstep = (size_t)(BK * 2);
    const size_t hstep = (size_t)HALF * K * 2;
    const size_t tstep = 2 * hstep;
    const unsigned ldsw = (unsigned)wid * 1024u;
    const int aoff = lds_byte(wr * 64 + fr, fq * 8), boff = lds_byte(wc * 32 + fr, fq * 8);
#define PG8_SA(b, h) (((b) * 2 + (h)) * HTB)
#define PG8_SB(b, h) ((4 + (b) * 2 + (h)) * HTB)
#define PG8_STAGE(bufoff, gbase, voff) do { _Pragma("unroll") for (int _i = 0; _i < 2; ++_i) \
        __builtin_amdgcn_global_load_lds((const unsigned*)((const char*)(gbase) + (voff)[_i]), (PG8_LAS unsigned*)(lds + (bufoff) + ldsw + _i * 8192), 16, 0, 0); } while (0)
#define PG8_LDA(dst, b, h) do { _Pragma("unroll") for (int m = 0; m < 4; ++m) _Pragma("unroll") for (int k = 0; k < 2; ++k) dst[m][k] = *(const PG8_LAS bf16x8*)(lds + PG8_SA(b, h) + aoff + m * 2048 + k * 1024); } while (0)
#define PG8_LDB(dst, b, h) do { _Pragma("unroll") for (int n = 0; n < 2; ++n) _Pragma("unroll") for (int k = 0; k < 2; ++k) dst[n][k] = *(const PG8_LAS bf16x8*)(lds + PG8_SB(b, h) + boff + n * 2048 + k * 1024); } while (0)
#define PG8_MMA(ai, bj, At, Bt) do { __builtin_amdgcn_s_setprio(1); _Pragma("unroll") for (int m = 0; m < 4; ++m) _Pragma("unroll") for (int n = 0; n < 2; ++n) _Pragma("unroll") for (int k = 0; k < 2; ++k) \
        acc[ai][bj][m][n] = __builtin_amdgcn_mfma_f32_16x16x32_bf16(Bt[n][k], At[m][k], acc[ai][bj][m][n], 0, 0, 0); __builtin_amdgcn_s_setprio(0); } while (0)
#define PG8_WAIT_V(n) asm volatile("s_waitcnt vmcnt(" #n ")" ::: "memory")
#define PG8_WAIT_L(n) asm volatile("s_waitcnt lgkmcnt(" #n ")" ::: "memory")
#define PG8_BAR __builtin_amdgcn_s_barrier()
#define PG8_SCHED __builtin_amdgcn_sched_barrier(0)
    Unit cur, nxt; int ui = 0;
    if (!S.next(0, cur)) return;
    f32x4 acc[2][2][4][2];
#pragma unroll
    for (int a = 0; a < 2; ++a)
#pragma unroll
        for (int b = 0; b < 2; ++b)
#pragma unroll
            for (int m = 0; m < 4; ++m)
#pragma unroll
                for (int n = 0; n < 2; ++n) acc[a][b][m][n] = (f32x4){0.f, 0.f, 0.f, 0.f};
    bf16x8 At[4][2], B0[2][2], B1[2][2];
    const char* cA = (const char*)g.A + (size_t)cur.pm * tstep; const char* cB = (const char*)g.Bt + (size_t)cur.pn * tstep;
    S.a_ready(cur);
    if constexpr (SP2) {
        PG8_STAGE(PG8_SB(0, 0), cB, voffB); PG8_STAGE(PG8_SB(0, 1), cB + hstep, voffB); PG8_STAGE(PG8_SA(0, 0), cA, voffA); PG8_STAGE(PG8_SA(0, 1), cA + hstep, voffA);
        if (wr == 1) PG8_BAR;
        PG8_WAIT_V(2); PG8_BAR;
        PG8_STAGE(PG8_SB(1, 0), cB + kstep, voffB); PG8_STAGE(PG8_SA(1, 0), cA + kstep, voffA); PG8_STAGE(PG8_SB(1, 1), cB + hstep + kstep, voffB);
        PG8_WAIT_V(6); PG8_BAR;
    } else {
        PG8_STAGE(PG8_SB(0, 0), cB, voffB); PG8_STAGE(PG8_SA(0, 0), cA, voffA); PG8_STAGE(PG8_SB(0, 1), cB + hstep, voffB); PG8_STAGE(PG8_SA(0, 1), cA + hstep, voffA);
        if (wr == 1) PG8_BAR;
        PG8_WAIT_V(4); PG8_BAR;
        PG8_STAGE(PG8_SB(1, 0), cB + kstep, voffB); PG8_STAGE(PG8_SA(1, 0), cA + kstep, voffA); PG8_STAGE(PG8_SB(1, 1), cB + hstep + kstep, voffB);
        PG8_WAIT_V(6); PG8_BAR;
    }
    for (;;) {
        const bool has_next = S.next(ui + 1, nxt);
        const char* nA = has_next ? (const char*)g.A + (size_t)nxt.pm * tstep : cA; const char* nB = has_next ? (const char*)g.Bt + (size_t)nxt.pn * tstep : cB;
        for (int t = 0; t < nt; t += 2) {
            const bool last = (t == nt - 2);
            const char* a1 = cA + (size_t)(t + 1) * kstep;
            const char* a2 = last ? nA : cA + (size_t)(t + 2) * kstep; const char* b2 = last ? nB : cB + (size_t)(t + 2) * kstep;
            const char* a3 = a2 + kstep; const char* b3 = b2 + kstep;
            if (last && has_next) S.a_ready(nxt);
            if constexpr (SP2) {
            PG8_LDB(B0, 0, 0); PG8_LDB(B1, 0, 1); PG8_SCHED; PG8_LDA(At, 0, 0); PG8_STAGE(PG8_SA(1, 1), a1 + hstep, voffA);
            PG8_WAIT_V(8); PG8_WAIT_L(0); PG8_BAR; PG8_MMA(0, 0, At, B0); PG8_MMA(0, 1, At, B1); PG8_BAR; PG8_SCHED;
            PG8_LDA(At, 0, 1); PG8_STAGE(PG8_SB(0, 0), b2, voffB); PG8_STAGE(PG8_SB(0, 1), b2 + hstep, voffB); PG8_STAGE(PG8_SA(0, 0), a2, voffA);
            PG8_WAIT_V(8); PG8_WAIT_L(0); PG8_BAR; PG8_MMA(1, 0, At, B0); PG8_MMA(1, 1, At, B1); PG8_BAR; PG8_SCHED;
            PG8_LDB(B0, 1, 0); PG8_LDB(B1, 1, 1); PG8_SCHED; PG8_LDA(At, 1, 0); PG8_STAGE(PG8_SA(0, 1), a2 + hstep, voffA);
            PG8_WAIT_V(8); PG8_WAIT_L(0); PG8_BAR; PG8_MMA(0, 0, At, B0); PG8_MMA(0, 1, At, B1); PG8_BAR; PG8_SCHED;
            PG8_LDA(At, 1, 1); PG8_STAGE(PG8_SB(1, 0), b3, voffB); PG8_STAGE(PG8_SB(1, 1), b3 + hstep, voffB); PG8_STAGE(PG8_SA(1, 0), a3, voffA);
            PG8_WAIT_V(8); PG8_WAIT_L(0); PG8_BAR; PG8_MMA(1, 0, At, B0); PG8_MMA(1, 1, At, B1); PG8_BAR; PG8_SCHED;
            } else {
            PG8_LDB(B0, 0, 0); PG8_SCHED; PG8_LDA(At, 0, 0); PG8_STAGE(PG8_SA(1, 1), a1 + hstep, voffA);
            PG8_WAIT_L(8); PG8_BAR; PG8_WAIT_L(0); PG8_MMA(0, 0, At, B0); PG8_BAR; PG8_SCHED;
            PG8_LDB(B1, 0, 1); PG8_STAGE(PG8_SB(0, 0), b2, voffB);
            PG8_BAR; PG8_WAIT_L(0); PG8_MMA(0, 1, At, B1); PG8_BAR;
            PG8_LDA(At, 0, 1); PG8_STAGE(PG8_SA(0, 0), a2, voffA);
            PG8_BAR; PG8_WAIT_L(0); PG8_MMA(1, 0, At, B0); PG8_BAR; PG8_SCHED;
            PG8_STAGE(PG8_SB(0, 1), b2 + hstep, voffB);
            PG8_WAIT_V(6); PG8_BAR; PG8_MMA(1, 1, At, B1); PG8_BAR;
            PG8_LDB(B0, 1, 0); PG8_SCHED; PG8_LDA(At, 1, 0); PG8_STAGE(PG8_SA(0, 1), a2 + hstep, voffA);
            PG8_WAIT_L(8); PG8_BAR; PG8_WAIT_L(0); PG8_MMA(0, 0, At, B0); PG8_BAR; PG8_SCHED;
            PG8_LDB(B1, 1, 1); PG8_STAGE(PG8_SB(1, 0), b3, voffB);
            PG8_BAR; PG8_WAIT_L(0); PG8_MMA(0, 1, At, B1); PG8_BAR;
            PG8_LDA(At, 1, 1); PG8_STAGE(PG8_SA(1, 0), a3, voffA);
            PG8_BAR; PG8_WAIT_L(0); PG8_MMA(1, 0, At, B0); PG8_BAR; PG8_SCHED;
            PG8_STAGE(PG8_SB(1, 1), b3 + hstep, voffB);
            PG8_WAIT_V(6); PG8_BAR; PG8_MMA(1, 1, At, B1); PG8_BAR;
            }
        }
        if constexpr (ALIGN_EPI) { if (wr == 0) PG8_BAR; }
        if constexpr (!Epi::AFTER_DRAIN) { E(acc, cur, wr, wc, fr, fq); S.done(cur); }
        if (!has_next) break;
#pragma unroll
        for (int a = 0; a < 2; ++a)
#pragma unroll
            for (int b = 0; b < 2; ++b)
#pragma unroll
                for (int m = 0; m < 4; ++m)
#pragma unroll
                    for (int n = 0; n < 2; ++n) acc[a][b][m][n] = (f32x4){0.f, 0.f, 0.f, 0.f};
        cur = nxt; cA = nA; cB = nB; ++ui;
        if constexpr (ALIGN_EPI) { if (wr == 1) PG8_BAR; }
    }
    PG8_WAIT_V(0);
    if constexpr (!ALIGN_EPI) { if (wr == 0) PG8_BAR; }
    PG8_BAR;
    if constexpr (Epi::AFTER_DRAIN) { E.fused(acc, cur, wr, wc, fr, fq, lds, wid, lane); S.done(cur); }
#undef PG8_SA
#undef PG8_SB
#undef PG8_STAGE
#undef PG8_LDA
#undef PG8_LDB
#undef PG8_MMA
#undef PG8_WAIT_V
#undef PG8_WAIT_L
#undef PG8_BAR
#undef PG8_SCHED
}
}
#ifndef PG8_SP2
#define PG8_SP2 true
#endif
#ifndef PG8_ALIGN
#define PG8_ALIGN true
#endif
constexpr int NWAVES = 8;
#ifndef MK_N_LAUNCHES
#define MK_N_LAUNCHES 1
#endif
constexpr int N_LAUNCHES = MK_N_LAUNCHES;
constexpr int PER_PHASE = 10;

constexpr int BATCH = 16, SEQ = 2048, D = 1024, M = BATCH * SEQ;
constexpr int HW = 512;
constexpr int NHEAD = 8, HD = 64;
constexpr int PEER_H = 8, PEER_DK = 256, DHALF = 128, NKEYS = 128, NEXP = NKEYS * NKEYS, TOPK = 16, NSEL = PEER_H * TOPK;
constexpr float EPS = 1e-6f;
constexpr float QSCALE = 0.125f * 1.4426950408889634f;
constexpr float SB_EXIT = 152.0f;

constexpr size_t MiB = 1u << 20;
constexpr size_t WS_CTL = 0, CTL_ZERO_BYTES = 2 * MiB;
constexpr size_t WS_SSQ1 = 1 * MiB;
constexpr size_t WS_WIN = 2 * MiB, WS_WOUT = 8 * MiB, WS_WQ = 10 * MiB, WS_KEYS = 14 * MiB;
constexpr size_t WS_SSQ2 = 1 * MiB + 256 * 1024;
constexpr size_t WS_SU = 15 * MiB, WS_SV = 15 * MiB + 256 * 1024;
constexpr size_t WS_XS = 15 * MiB + 512 * 1024;
constexpr size_t WS_PFX = 14 * MiB + 512 * 1024;
constexpr size_t WS_XQ = 272 * MiB;
constexpr size_t WS_UQ = 16 * MiB;
constexpr size_t WS_VQ = 32 * MiB;
constexpr size_t WS_XN = 80 * MiB;
constexpr size_t WS_Q = 144 * MiB;
constexpr size_t WS_VTR = 304 * MiB;
constexpr size_t WS_QP = 144 * MiB;
constexpr size_t WS_MIX = 336 * MiB;
constexpr size_t WS_IDX = 400 * MiB, WS_GW = 416 * MiB, WS_W = 432 * MiB, WS_X1B = 448 * MiB, WS_END = 512 * MiB;
constexpr int CW_TMO = 0, CW_CODE = 1;
constexpr int CW_BAR = 4096;
constexpr int CW_TICKET = 8192;

constexpr int RING_OFF = 0, RING_BYTES = 131072;
constexpr int LDSCTL_OFF = RING_BYTES, MISC_OFF = LDSCTL_OFF + 320;
constexpr int LDS_BYTES = 147456;
static_assert(MISC_OFF + 128 <= LDS_BYTES, "LDS map");
#define GAS __attribute__((address_space(1)))
#define LAS __attribute__((address_space(3)))
typedef unsigned short bf16;
typedef unsigned v4u __attribute__((ext_vector_type(4)));
typedef float f32x4 __attribute__((ext_vector_type(4)));
typedef short bf16x8 __attribute__((ext_vector_type(8)));
typedef GAS unsigned gu32;
typedef GAS unsigned long long gu64;
#define RLX_AGENT __ATOMIC_RELAXED, __HIP_MEMORY_SCOPE_AGENT
#define LDS_WAIT() asm volatile("s_waitcnt lgkmcnt(0)" ::: "memory")
#define VM_WAIT() asm volatile("s_waitcnt vmcnt(0)" ::: "memory")
__device__ __forceinline__ unsigned long long rt() { return __builtin_amdgcn_s_memrealtime(); }
__device__ __forceinline__ unsigned f2bf(float f) { unsigned u = __builtin_bit_cast(unsigned, f); return (u + 0x7fffu + ((u >> 16) & 1u)) >> 16; }
__device__ __forceinline__ unsigned pk2(float lo, float hi) { return f2bf(lo) | (f2bf(hi) << 16); }
#define XB_TMO      128
#define XB_XCNT(j)  (256  + 64 * (j))
#define XB_XSUB(j)  (1280 + 64 * (j))
#define XB_XGEN(j)  (2304 + 64 * (j))
#define XB_TOP      3328
#define XB_TOPGEN   3392
#define XCD_BAR_WORDS 3456
#define XB_SPIN_CAP (1u << 18)

__device__ __forceinline__ unsigned xb_ld(unsigned* p)              { return __hip_atomic_load(p, __ATOMIC_RELAXED, __HIP_MEMORY_SCOPE_AGENT); }
__device__ __forceinline__ unsigned xb_add(unsigned* p, unsigned v) { return __hip_atomic_fetch_add(p, v, __ATOMIC_RELAXED, __HIP_MEMORY_SCOPE_AGENT); }
__device__ __forceinline__ unsigned xb_xcc_id() { return (unsigned)__builtin_amdgcn_s_getreg((3 << 11) | 20) & 0xFu; }
#define XB_SPIN(cond, bar) do { unsigned _sp = 0; while (cond) { __builtin_amdgcn_s_sleep(1); \
    if ((++_sp & 255u) == 0u) { if (xb_ld(&(bar)[XB_TMO])) break; if (_sp > XB_SPIN_CAP) { atomicAdd(&(bar)[XB_TMO], 1u); break; } } } } while (0)

struct XcdBarrier {
    unsigned* bar; unsigned x;
    volatile LAS unsigned* st;
};

__device__ __forceinline__ XcdBarrier xcd_barrier_post(unsigned* bar, volatile LAS unsigned* st) {
    XcdBarrier b; b.bar = bar; b.x = xb_xcc_id(); b.st = st;
    if (threadIdx.x == 0) (void)xb_add(&bar[XB_XCNT(b.x)], 1u);
    return b;
}
__device__ __forceinline__ void xcd_barrier_complete(unsigned* bar, unsigned x, unsigned& nloc, unsigned& nx) {
    const unsigned G = gridDim.x * gridDim.y * gridDim.z;
    unsigned sum, cnt, mine, sp = 0u;
    for (;;) {
        sum = 0u; cnt = 0u; mine = 0u;
#pragma unroll
        for (unsigned j = 0; j < 16; ++j) { const unsigned c = xb_ld(&bar[XB_XCNT(j)]); sum += c; cnt += (c > 0u) ? 1u : 0u; mine = (j == x) ? c : mine; }
        if (sum == G) break;
        __builtin_amdgcn_s_sleep(1);
        if ((++sp & 255u) == 0u) { if (xb_ld(&bar[XB_TMO])) break; if (sp > XB_SPIN_CAP) { atomicAdd(&bar[XB_TMO], 1u); break; } }
    }
    nloc = mine > 0u ? mine : 1u; nx = cnt > 0u ? cnt : 1u;
}

__device__ __forceinline__ void xcd_barrier(const XcdBarrier& b) {
    asm volatile("s_waitcnt vmcnt(0)" ::: "memory");
    __syncthreads();
    if (threadIdx.x == 0) {
        unsigned* bar = b.bar;
        __builtin_amdgcn_s_waitcnt(0);
        unsigned nloc = b.st[0], nx = b.st[1];
        if (nloc == 0u) { xcd_barrier_complete(bar, b.x, nloc, nx); b.st[0] = nloc; b.st[1] = nx; }
        const unsigned old = xb_add(&bar[XB_XSUB(b.x)], 1u);
        const unsigned gen = old / nloc;
        if (old + 1u == (gen + 1u) * nloc) {
            __builtin_amdgcn_fence(__ATOMIC_RELEASE, "agent");
            asm volatile("s_waitcnt vmcnt(0)" ::: "memory");
            const unsigned og = xb_add(&bar[XB_TOP], 1u);
            const unsigned tg = og / nx;
            if (og + 1u == (tg + 1u) * nx) xb_add(&bar[XB_TOPGEN], 1u);
            else XB_SPIN(xb_ld(&bar[XB_TOPGEN]) == tg, bar);
            __builtin_amdgcn_fence(__ATOMIC_ACQUIRE, "agent");
            xb_add(&bar[XB_XGEN(b.x)], 1u);
            asm volatile("s_waitcnt vmcnt(0)" ::: "memory");
        } else {
            XB_SPIN(xb_ld(&bar[XB_XGEN(b.x)]) == gen, bar);
            __builtin_amdgcn_fence(__ATOMIC_ACQUIRE, "agent");
            asm volatile("s_waitcnt vmcnt(0)" ::: "memory");
        }
    }
    __syncthreads();
}

typedef float f32x16 __attribute__((ext_vector_type(16)));
typedef short s16x4 __attribute__((ext_vector_type(4)));
typedef unsigned v2u __attribute__((ext_vector_type(2)));
struct Frame {
    LAS unsigned char* lds;
    volatile LAS unsigned* MISC;
    gu32* ctl;
    int tid, lane, wave;
    int vcu, G;
    const float *x, *mix_g, *w_in, *conv_w, *conv_b, *attn_g, *conv_g, *w_out, *ffn_g, *wq, *keys, *pu, *pv, *fin_g;
    float* out;
    bf16 *WinT, *WoutT, *WqT, *KEYSB, *XN, *Q, *K, *GB, *UU, *VTR, *QP, *MIX;
    unsigned char *UQ, *VQ, *XQ; bf16 *X2B, *X1B; float *SU, *SV, *XS;
    float *SSQ1; unsigned *IG, *IGS, *PFX, *WP;
};

__device__ __forceinline__ int lane_id() { return (int)__builtin_amdgcn_mbcnt_hi(~0u, __builtin_amdgcn_mbcnt_lo(~0u, 0u)); }
template <int CTRL> __device__ __forceinline__ float dppf(float v) { return __int_as_float(__builtin_amdgcn_update_dpp(0, __float_as_int(v), CTRL, 0xf, 0xf, false)); }
__device__ __forceinline__ float swz16f(float v) { return __int_as_float(__builtin_amdgcn_ds_swizzle(__float_as_int(v), 0x1f | (16 << 10))); }
__device__ __forceinline__ float wave_sum(float v) {
    v += dppf<0xb1>(v); v += dppf<0x4e>(v); v += dppf<0x141>(v); v += dppf<0x128>(v); v += swz16f(v);
    auto rr = __builtin_amdgcn_permlane32_swap(__float_as_uint(v), __float_as_uint(v), false, false); return __uint_as_float(rr[0]) + __uint_as_float(rr[1]);
}
__device__ __forceinline__ float wave_max(float v) {
    v = __builtin_fmaxf(v, dppf<0xb1>(v)); v = __builtin_fmaxf(v, dppf<0x4e>(v)); v = __builtin_fmaxf(v, dppf<0x141>(v)); v = __builtin_fmaxf(v, dppf<0x128>(v)); v = __builtin_fmaxf(v, swz16f(v));
    auto rr = __builtin_amdgcn_permlane32_swap(__float_as_uint(v), __float_as_uint(v), false, false); return __builtin_fmaxf(__uint_as_float(rr[0]), __uint_as_float(rr[1]));
}
__device__ __forceinline__ float bf_lo(unsigned w) { return __uint_as_float(w << 16); }
__device__ __forceinline__ float bf_hi(unsigned w) { return __uint_as_float(w & 0xffff0000u); }
typedef float f32x2_t __attribute__((ext_vector_type(2))); typedef __bf16 bf16x2_t __attribute__((ext_vector_type(2))); typedef _Float16 h2_t __attribute__((ext_vector_type(2)));
__device__ __forceinline__ unsigned cvtpk(float lo, float hi) { f32x2_t v = {lo, hi}; bf16x2_t b = __builtin_convertvector(v, bf16x2_t); return __builtin_bit_cast(unsigned, b); }

__device__ __forceinline__ void p0_transpose_item(const float* W, int ldw, int K, int ncols, bf16* WT, int row_off, LAS float* scr, int item, int lane, const float* kgain = nullptr) {
    const int nblk = ncols / 32, kb = item / nblk, nb = item % nblk, k0 = 64 * kb, n0 = 32 * nb;
#pragma unroll 8
    for (int i = 0; i < 32; ++i) { const int kk = 2 * i + (lane >> 5); const float gk = kgain ? kgain[k0 + kk] : 1.f; scr[kk * 33 + (lane & 31)] = gk * W[(size_t)(k0 + kk) * ldw + n0 + (lane & 31)]; }
    LDS_WAIT(); asm volatile("" ::: "memory");
    const int c = lane & 7;
#pragma unroll
    for (int j = 0; j < 4; ++j) { const int n = (lane >> 3) + 8 * j; const LAS float* s = scr + (8 * c) * 33 + n;
        v4u o; o.x = pk2(s[0 * 33], s[1 * 33]); o.y = pk2(s[2 * 33], s[3 * 33]); o.z = pk2(s[4 * 33], s[5 * 33]); o.w = pk2(s[6 * 33], s[7 * 33]);
        *(GAS v4u*)(WT + (size_t)(row_off + n0 + n) * K + k0 + 8 * c) = o; }
    LDS_WAIT(); asm volatile("" ::: "memory");
}
__device__ __forceinline__ void p0_convert(const float* src, bf16* dst, size_t n8, size_t gt, size_t NGT) {
    for (size_t i = gt; i < n8; i += NGT) {
        const f32x4 a = ((const GAS f32x4*)src)[2 * i], b = ((const GAS f32x4*)src)[2 * i + 1];
        v4u o; o.x = pk2(a.x, a.y); o.y = pk2(a.z, a.w); o.z = pk2(b.x, b.y); o.w = pk2(b.z, b.w);
        ((GAS v4u*)dst)[i] = o; }
}
__device__ __forceinline__ void rms_rows2_to_bf16(Frame& F, const float* x0, const float* x1, const float* g, bf16* o0, bf16* o1, bool ok1) {
    const GAS f32x4* xr0 = (const GAS f32x4*)x0 + F.lane; const GAS f32x4* xr1 = (const GAS f32x4*)x1 + F.lane; const GAS f32x4* gr = (const GAS f32x4*)g + F.lane;
    f32x4 v[4], w[4]; float s = 0.f, t = 0.f;
#pragma unroll
    for (int j = 0; j < 4; ++j) { v[j] = __builtin_nontemporal_load(xr0 + 64 * j); w[j] = __builtin_nontemporal_load(xr1 + 64 * j); }
#pragma unroll
    for (int j = 0; j < 4; ++j) { s += (v[j].x * v[j].x + v[j].y * v[j].y) + (v[j].z * v[j].z + v[j].w * v[j].w); t += (w[j].x * w[j].x + w[j].y * w[j].y) + (w[j].z * w[j].z + w[j].w * w[j].w); }
    const float r0 = rsqrtf(wave_sum(s) * (1.f / D) + EPS), r1 = rsqrtf(wave_sum(t) * (1.f / D) + EPS);
    GAS unsigned long long* p0 = (GAS unsigned long long*)o0 + F.lane; GAS unsigned long long* p1 = (GAS unsigned long long*)o1 + F.lane;
#pragma unroll
    for (int j = 0; j < 4; ++j) { const f32x4 gg = gr[64 * j];
        p0[64 * j] = (unsigned long long)pk2(v[j].x * r0 * gg.x, v[j].y * r0 * gg.y) | ((unsigned long long)pk2(v[j].z * r0 * gg.z, v[j].w * r0 * gg.w) << 32);
        if (ok1) p1[64 * j] = (unsigned long long)pk2(w[j].x * r1 * gg.x, w[j].y * r1 * gg.y) | ((unsigned long long)pk2(w[j].z * r1 * gg.z, w[j].w * r1 * gg.w) << 32); }
}
__device__ __forceinline__ void p0_quant_row(Frame& F, const f32x4 (&v)[4], int e) {
    const bool isv = e >= NEXP; const int r = isv ? e - NEXP : e;
    float am = 0.f;
#pragma unroll
    for (int j = 0; j < 4; ++j) { am = __builtin_fmaxf(am, __builtin_fmaxf(__builtin_fmaxf(__builtin_fabsf(v[j].x), __builtin_fabsf(v[j].y)), __builtin_fmaxf(__builtin_fabsf(v[j].z), __builtin_fabsf(v[j].w)))); }
    am = wave_max(am);
    const float qmax = 6.f;
    const float inv = am > 0.f ? qmax / am : 0.f;
    v4u o;
#pragma unroll
    for (int j = 0; j < 4; ++j) { unsigned p = 0u; p = __builtin_amdgcn_cvt_scalef32_pk_fp4_f32(p, v[j].x * inv, v[j].y * inv, 1.0f, 0); p = __builtin_amdgcn_cvt_scalef32_pk_fp4_f32(p, v[j].z * inv, v[j].w * inv, 1.0f, 1); o[j] = p; }
    unsigned char* const tab = isv ? F.VQ : F.UQ;
#pragma unroll
    for (int j = 0; j < 4; ++j) __builtin_nontemporal_store((unsigned short)o[j], (GAS unsigned short*)(tab + ((size_t)j * NEXP + r) * 128 + 2 * F.lane));
    if (F.lane == 0) F.SU[2 * r + (isv ? 1 : 0)] = am > 0.f ? am / qmax : 1.f;
}
#ifndef MK_QSPLIT
#define MK_QSPLIT 23552
#endif
constexpr int Q_SPLIT = MK_QSPLIT;
__device__ __forceinline__ void p0_quant_rows(Frame& F, const int gw, const int NGW, const int e_lo, const int e_hi) {
    constexpr int QG = 4;
    const int nrows = e_lo + gw < e_hi ? (e_hi - e_lo - gw + NGW - 1) / NGW : 0;
#define P0_QLOAD(buf, i0_) do { _Pragma("unroll") for (int q_ = 0; q_ < QG; ++q_) { const int i_ = (i0_) + q_ < nrows ? (i0_) + q_ : (nrows > 0 ? nrows - 1 : 0); const int e_ = nrows > 0 ? e_lo + gw + i_ * NGW : 0; \
        const GAS f32x4* src_ = (const GAS f32x4*)((e_ >= NEXP ? F.pv : F.pu) + (size_t)(e_ >= NEXP ? e_ - NEXP : e_) * D) + F.lane; \
        _Pragma("unroll") for (int j_ = 0; j_ < 4; ++j_) buf[q_][j_] = __builtin_nontemporal_load(src_ + 64 * j_); } } while (0)
#define P0_QROWS(buf, i0_) do { _Pragma("unroll") for (int q_ = 0; q_ < QG; ++q_) { if ((i0_) + q_ < nrows) p0_quant_row(F, buf[q_], e_lo + gw + ((i0_) + q_) * NGW); } } while (0)
    f32x4 qa[QG][4], qb[QG][4];
    if (nrows > 0) P0_QLOAD(qa, 0);
    for (int i0 = 0; i0 < nrows; i0 += 2 * QG) {
        if (i0 + QG < nrows) P0_QLOAD(qb, i0 + QG);
        P0_QROWS(qa, i0);
        if (i0 + 2 * QG < nrows) P0_QLOAD(qa, i0 + 2 * QG);
        P0_QROWS(qb, i0 + QG);
    }
#undef P0_QLOAD
#undef P0_QROWS
}
template <int PART> __device__ __forceinline__ void p0_prologue(Frame& F, const int gw, const int NGW) {
    LAS float* scr = (LAS float*)(F.lds + RING_OFF + (PART ? 49152 + F.wave * 10240 : F.wave * 16384));
    constexpr int I0 = (D / 64) * (1024 / 32), I1 = (D / 64) * (512 / 32), I2 = (D / 64) * (512 / 32), IG = (D / 64) * (128 / 32), I3 = (D / 64) * (D / 32), I4 = (D / 64) * (2048 / 32);
    constexpr int NITEMS = I0 + I1 + I2 + 8 * IG + I3 + I4;
    constexpr int NIN = I0 + I1 + I2 + 8 * IG;
    for (int it = (PART ? NIN : 0) + gw; it < (PART ? NITEMS : NIN); it += NGW) {
        int r = it;
        if (r < I0) { p0_transpose_item(F.w_in, 3072, D, 1024, F.WinT, 0, scr, r, F.lane); continue; } r -= I0;
        if (r < I1) { p0_transpose_item(F.w_in + 1024, 3072, D, 512, F.WinT, 2560, scr, r, F.lane); continue; } r -= I1;
        if (r < I2) { p0_transpose_item(F.w_in + 1536, 3072, D, 512, F.WinT, 1024, scr, r, F.lane); continue; } r -= I2;
        if (r < 8 * IG) { const int seg = r / IG, T = seg >> 1, ishc = seg & 1;
            p0_transpose_item(F.w_in + 2048 + 512 * ishc + 128 * T, 3072, D, 128, F.WinT, 1536 + 256 * T + 128 * ishc, scr, r % IG, F.lane); continue; } r -= 8 * IG;
        if (r < I3) { p0_transpose_item(F.w_out, D, D, D, F.WoutT, 0, scr, r, F.lane); continue; } r -= I3;
        p0_transpose_item(F.wq, 2048, D, 2048, F.WqT, 0, scr, r, F.lane, F.ffn_g);
    }
    if (PART == 0) {
        for (int m = gw; m < M; m += 2 * NGW) { const bool ok1 = m + NGW < M; const int m1 = ok1 ? m + NGW : m;
            rms_rows2_to_bf16(F, F.x + (size_t)m * D, F.x + (size_t)m1 * D, F.mix_g, F.XN + (size_t)m * D, F.XN + (size_t)m1 * D, ok1); }
        return;
    }
    const size_t gt = (size_t)gw * 64 + F.lane, NGT = (size_t)NGW * 64;
    p0_convert(F.keys, F.KEYSB, (size_t)2 * PEER_H * NKEYS * DHALF / 8, gt, NGT);
    p0_quant_rows(F, gw, NGW, 0, Q_SPLIT);
}

__device__ __forceinline__ int crow(int r, int hi) { return (r & 3) + 8 * (r >> 2) + 4 * hi; }
constexpr int ATT_WAVES = 4;
__device__ __forceinline__ void attn_head_tiles(Frame& F, const int h, const size_t brow, const int qb, const int lane, f32x16& o0_out, f32x16& o1_out) {
    const int q32 = lane & 31, hi = lane >> 5, t0 = qb * 32;
        bf16x8 qf[4];
        { const bf16* Qp = F.Q + ((((brow + t0) >> 5) * 8 + h) * 8 * 32 + hi * 32 + q32) * 8;
#pragma unroll
          for (int ks = 0; ks < 4; ++ks) qf[ks] = *(const bf16x8*)(Qp + ks * 512); }
        f32x16 o0 = {}, o1 = {}; float c = 0.f;
        const bf16* const Kb = F.K + (((brow >> 5) * 8 + h) * 8 * 32 + hi * 32 + q32) * 8;
        const bf16* const Vb = F.VTR + (((brow >> 5) * 8 + h) * 16 * 32 + hi * 32 + q32) * 4;
#define ATT_LOAD(KF, VA, VB, key0_) do { const size_t to_ = (size_t)((key0_) >> 5) * (8 * 2048); \
            _Pragma("unroll") for (int ks = 0; ks < 4; ++ks) KF[ks] = *(const bf16x8*)(Kb + to_ + ks * 512); \
            _Pragma("unroll") for (int db = 0; db < 2; ++db) _Pragma("unroll") for (int s_ = 0; s_ < 2; ++s_) { \
                VA[db][s_] = *(const s16x4*)(Vb + to_ + ((db * 2 + s_) * 2 + 0) * 256); VB[db][s_] = *(const s16x4*)(Vb + to_ + ((db * 2 + s_) * 2 + 1) * 256); } } while (0)
        struct KV { bf16x8 k[4]; s16x4 va[2][2], vb[2][2]; };
        KV A, B, C;
        ATT_LOAD(A.k, A.va, A.vb, qb * 32);
        { const int kp = qb > 0 ? qb - 1 : 0; ATT_LOAD(B.k, B.va, B.vb, kp * 32); }
        auto step = [&](const KV& X, KV& Y, const int kt) -> bool {
            { const int kp = kt > 1 ? kt - 2 : 0; ATT_LOAD(Y.k, Y.va, Y.vb, kp * 32); }
            f32x16 S = {};
#pragma unroll
            for (int ks = 0; ks < 4; ++ks) S = __builtin_amdgcn_mfma_f32_32x32x16_bf16(X.k[ks], qf[ks], S, 0, 0, 0);
            const bool diag = (kt == qb);
            float u[16];
#pragma unroll
            for (int r = 0; r < 16; ++r) { const float uu = __builtin_amdgcn_exp2f(__builtin_amdgcn_fmed3f(S[r], -__builtin_inff(), 30.f));   u[r] = (!diag || (crow(r, hi) < q32)) ? uu : 0.f; }
            float pin0[4], pre[16], T[4];
#pragma unroll
            for (int g = 0; g < 4; ++g) { const float w0 = 1.f + u[4 * g], w1 = 1.f + u[4 * g + 1], w2 = 1.f + u[4 * g + 2], w3 = 1.f + u[4 * g + 3];
                pre[4 * g] = 1.f; pre[4 * g + 1] = w0; pre[4 * g + 2] = w0 * w1; pre[4 * g + 3] = pre[4 * g + 2] * w2;
                pin0[g] = pre[4 * g + 3] * w3; T[g] = -__builtin_amdgcn_logf(pin0[g]); }
            float Lh[4], Hh[4];
#pragma unroll
            for (int g = 0; g < 4; ++g) { auto rr = __builtin_amdgcn_permlane32_swap(__float_as_uint(T[g]), __float_as_uint(T[g]), false, false); Lh[g] = __uint_as_float(rr[0]); Hh[g] = __uint_as_float(rr[1]); }
            float A[4]; A[3] = 0.f;
#pragma unroll
            for (int g = 2; g >= 0; --g) A[g] = A[g + 1] + (Lh[g + 1] + Hh[g + 1]);
            const float total = A[0] + (Lh[0] + Hh[0]);
            float a[16];
#pragma unroll
            for (int g = 0; g < 4; ++g) { const float R = __builtin_amdgcn_exp2f(A[g] + (hi ? 0.f : Hh[g]) + c) * __builtin_amdgcn_rcpf(pin0[g]);
#pragma unroll
                for (int j = 0; j < 4; ++j) a[4 * g + j] = (u[4 * g + j] * pre[4 * g + j]) * R; }
            c += total;
#pragma unroll
            for (int s = 0; s < 2; ++s) {
                v4u pw; pw.x = cvtpk(a[8 * s], a[8 * s + 1]); pw.y = cvtpk(a[8 * s + 2], a[8 * s + 3]); pw.z = cvtpk(a[8 * s + 4], a[8 * s + 5]); pw.w = cvtpk(a[8 * s + 6], a[8 * s + 7]);
                const bf16x8 pb = __builtin_bit_cast(bf16x8, pw);
                const bf16x8 v0 = (bf16x8){X.va[0][s][0], X.va[0][s][1], X.va[0][s][2], X.va[0][s][3], X.vb[0][s][0], X.vb[0][s][1], X.vb[0][s][2], X.vb[0][s][3]};
                const bf16x8 v1 = (bf16x8){X.va[1][s][0], X.va[1][s][1], X.va[1][s][2], X.va[1][s][3], X.vb[1][s][0], X.vb[1][s][1], X.vb[1][s][2], X.vb[1][s][3]};
                o0 = __builtin_amdgcn_mfma_f32_32x32x16_bf16(v0, pb, o0, 0, 0, 0);
                o1 = __builtin_amdgcn_mfma_f32_32x32x16_bf16(v1, pb, o1, 0, 0, 0);
            }
            return __all(c < -SB_EXIT);
        };
        for (int kt = qb;;) {
            if (step(A, C, kt) || --kt < 0) break;
            if (step(B, A, kt) || --kt < 0) break;
            if (step(C, B, kt) || --kt < 0) break;
        }
#undef ATT_LOAD
        o0_out = o0; o1_out = o1;
}
__device__ __forceinline__ void att_sync(volatile LAS unsigned* cnt, unsigned target, int lane) {
    LDS_WAIT();
    if (lane == 0) (void)__hip_atomic_fetch_add((LAS unsigned*)cnt, 1u, __ATOMIC_RELAXED, __HIP_MEMORY_SCOPE_WORKGROUP);
    while (*cnt < target) __builtin_amdgcn_s_sleep(1);
    asm volatile("" ::: "memory");
}
__device__ __forceinline__ void attn_store_head(Frame& F, const int h, const f32x16& o0, const f32x16& o1, const float rinv, const size_t brow, const int t0, const int lane) {
    const int q32 = lane & 31, hi = lane >> 5;
        LAS unsigned char* stg = F.lds + RING_OFF + 4096 + F.wave * 4608;
        const float* gp = F.attn_g + h * HD + 4 * hi;
#pragma unroll
        for (int db = 0; db < 2; ++db)
#pragma unroll
            for (int g = 0; g < 4; ++g) {
                const f32x4 gg = *(const f32x4*)(gp + db * 32 + 8 * g);
                const f32x16& o = db ? o1 : o0;
                v2u w; w.x = cvtpk(o[4 * g] * rinv * gg.x, o[4 * g + 1] * rinv * gg.y); w.y = cvtpk(o[4 * g + 2] * rinv * gg.z, o[4 * g + 3] * rinv * gg.w);
                *(LAS v2u*)(stg + q32 * 136 + (db * 32 + 8 * g + 4 * hi) * 2) = w;
            }
        LDS_WAIT();
#pragma unroll
        for (int p = 0; p < 4; ++p) { const int row = 8 * p + (lane >> 3);
            const v2u a = *(const LAS v2u*)(stg + row * 136 + (lane & 7) * 16), b = *(const LAS v2u*)(stg + row * 136 + (lane & 7) * 16 + 8);
            v4u w; w.x = a.x; w.y = a.y; w.z = b.x; w.w = b.y;
            *(v4u*)(F.MIX + (brow + t0 + row) * D + h * HD + (lane & 7) * 8) = w; }
        LDS_WAIT();
}
__device__ __forceinline__ void attn_phase(Frame& F) {
    const int lane = F.lane, q32 = lane & 31, hi = lane >> 5, w = F.wave;
    LAS float* ssq_lds = (LAS float*)(F.lds + RING_OFF);
    volatile LAS unsigned* cnt = (volatile LAS unsigned*)(F.lds + RING_OFF + 2048);
    constexpr int NUNIT = BATCH * (SEQ / 32);
    int par = 0; unsigned visit = 0u;
    for (int unit = F.vcu; unit < NUNIT; unit += F.G, par ^= 1) {
        const int b = unit >> 6, qb = unit & 63;
        const size_t brow = (size_t)b * SEQ; const int t0 = qb * 32;
        f32x16 oa0, oa1, ob0, ob1;
        attn_head_tiles(F, w, brow, qb, lane, oa0, oa1);
        attn_head_tiles(F, w + ATT_WAVES, brow, qb, lane, ob0, ob1);
        float sq = 0.f;
#pragma unroll
        for (int r = 0; r < 16; ++r) sq += (oa0[r] * oa0[r] + oa1[r] * oa1[r]) + (ob0[r] * ob0[r] + ob1[r] * ob1[r]);
        { auto rr = __builtin_amdgcn_permlane32_swap(__float_as_uint(sq), __float_as_uint(sq), false, false); sq = __uint_as_float(rr[0]) + __uint_as_float(rr[1]); }
        if (hi == 0) ssq_lds[(par * ATT_WAVES + w) * 32 + q32] = sq;
        visit += ATT_WAVES; att_sync(cnt, visit, lane);
        float tot = 0.f;
#pragma unroll
        for (int k = 0; k < ATT_WAVES; ++k) tot += ssq_lds[(par * ATT_WAVES + k) * 32 + q32];
        const float rinv = rsqrtf(tot * (1.f / HW) + EPS);
        attn_store_head(F, w, oa0, oa1, rinv, brow, t0, lane);
        attn_store_head(F, w + ATT_WAVES, ob0, ob1, rinv, brow, t0, lane);
    }
}
__device__ __forceinline__ void conv_phase(Frame& F, const int gw, const int NGW) {
    const int c8 = F.lane * 8;
    float w0[8], w1[8], w2[8], bb[8], gg[8];
#pragma unroll
    for (int i = 0; i < 8; ++i) { w0[i] = F.conv_w[c8 + i]; w1[i] = F.conv_w[HW + c8 + i]; w2[i] = F.conv_w[2 * HW + c8 + i]; bb[i] = F.conv_b[c8 + i]; gg[i] = F.conv_g[c8 + i]; }
    constexpr int RUN = 16;
    for (int chunk = gw; chunk < M / RUN; chunk += NGW) {
        const int r0 = chunk * RUN, t0 = r0 & (SEQ - 1);
        float u1[8], u2[8];
#pragma unroll
        for (int i = 0; i < 8; ++i) { u1[i] = 0.f; u2[i] = 0.f; }
        if (t0 >= 2) {
            const size_t off = (size_t)r0 * HW + c8;
            const v4u a1 = *(const v4u*)(F.UU + off - HW), a2 = *(const v4u*)(F.UU + off - 2 * HW);
#pragma unroll
            for (int i = 0; i < 4; ++i) { u1[2 * i] = bf_lo(a1[i]); u1[2 * i + 1] = bf_hi(a1[i]); u2[2 * i] = bf_lo(a2[i]); u2[2 * i + 1] = bf_hi(a2[i]); }
        }
        v4u gball[RUN], uall[RUN];
#pragma unroll
        for (int k = 0; k < RUN; ++k) { gball[k] = __builtin_nontemporal_load((const v4u*)(F.GB + (size_t)(r0 + k) * HW + c8)); uall[k] = __builtin_nontemporal_load((const v4u*)(F.UU + (size_t)(r0 + k) * HW + c8)); }
#pragma unroll
        for (int k = 0; k < RUN; ++k) {
            const v4u gbv = gball[k], uv = uall[k];
            const int row = r0 + k;
            float oc[8], u0[8]; float s = 0.f;
#pragma unroll
            for (int i = 0; i < 4; ++i) {
                u0[2 * i] = bf_lo(uv[i]); u0[2 * i + 1] = bf_hi(uv[i]);
                const float yl = w0[2 * i] * u2[2 * i] + w1[2 * i] * u1[2 * i] + w2[2 * i] * u0[2 * i] + bb[2 * i];
                const float yh = w0[2 * i + 1] * u2[2 * i + 1] + w1[2 * i + 1] * u1[2 * i + 1] + w2[2 * i + 1] * u0[2 * i + 1] + bb[2 * i + 1];
                oc[2 * i] = bf_lo(gbv[i]) * yl; oc[2 * i + 1] = bf_hi(gbv[i]) * yh;
                s += oc[2 * i] * oc[2 * i] + oc[2 * i + 1] * oc[2 * i + 1];
            }
            const float rinv = rsqrtf(wave_sum(s) * (1.f / HW) + EPS);
            v4u o;
            o.x = cvtpk(oc[0] * rinv * gg[0], oc[1] * rinv * gg[1]); o.y = cvtpk(oc[2] * rinv * gg[2], oc[3] * rinv * gg[3]);
            o.z = cvtpk(oc[4] * rinv * gg[4], oc[5] * rinv * gg[5]); o.w = cvtpk(oc[6] * rinv * gg[6], oc[7] * rinv * gg[7]);
            __builtin_nontemporal_store(o, (v4u*)(F.MIX + (size_t)row * D + HW + c8));
#pragma unroll
            for (int i = 0; i < 8; ++i) { u2[i] = u1[i]; u1[i] = u0[i]; }
        }
    }
}

__device__ __forceinline__ unsigned f2sortable(float f) { const unsigned u = __float_as_uint(f); return u ^ ((unsigned)((int)u >> 31) | 0x80000000u); }
__device__ __forceinline__ float sortable2f(unsigned s) { const unsigned u = (s & 0x80000000u) ? (s ^ 0x80000000u) : ~s; return __uint_as_float(u); }
__device__ __forceinline__ unsigned umax_(unsigned a, unsigned b) { return a > b ? a : b; }
__device__ __forceinline__ unsigned umin_(unsigned a, unsigned b) { return a < b ? a : b; }
struct Net16 { int i[63], j[63]; };
constexpr Net16 OE16 = { { 0, 2, 0, 1, 1, 4, 6, 4, 5, 5, 0, 2, 2, 1, 3, 3, 1, 3, 5, 8, 10, 8, 9, 9, 12, 14, 12, 13, 13, 8, 10, 10, 9, 11, 11, 9, 11, 13, 0, 4, 4, 2, 6, 6, 2, 6, 10, 1, 5, 5, 3, 7, 7, 3, 7, 11, 1, 3, 5, 7, 9, 11, 13 }, { 1, 3, 2, 3, 2, 5, 7, 6, 7, 6, 4, 6, 4, 5, 7, 5, 2, 4, 6, 9, 11, 10, 11, 10, 13, 15, 14, 15, 14, 12, 14, 12, 13, 15, 13, 10, 12, 14, 8, 12, 8, 10, 14, 10, 4, 8, 12, 9, 13, 9, 11, 15, 11, 5, 9, 13, 2, 4, 6, 8, 10, 12, 14 } };
__device__ __forceinline__ void sort16(unsigned (&a)[16]) {
#pragma unroll
    for (int c = 0; c < 63; ++c) { const unsigned mx = umax_(a[OE16.i[c]], a[OE16.j[c]]), mn = umin_(a[OE16.i[c]], a[OE16.j[c]]); a[OE16.i[c]] = mx; a[OE16.j[c]] = mn; }
}
__device__ __forceinline__ void merge16(unsigned (&a)[16], const unsigned (&b)[16]) {
#pragma unroll
    for (int i = 0; i < 16; ++i) a[i] = umax_(a[i], b[15 - i]);
#pragma unroll
    for (int j = 8; j > 0; j >>= 1)
#pragma unroll
        for (int i = 0; i < 16; ++i) { const int l = i ^ j; if (l > i) { const unsigned mx = umax_(a[i], a[l]), mn = umin_(a[i], a[l]); a[i] = mx; a[l] = mn; } }
}
__device__ __forceinline__ void merge_halves(unsigned (&a)[16]) {
    unsigned x[16], y[16];
#pragma unroll
    for (int i = 0; i < 16; ++i) { auto rr = __builtin_amdgcn_permlane32_swap(a[i], a[i], false, false); x[i] = rr[0]; y[i] = rr[1]; }
    merge16(x, y);
#pragma unroll
    for (int i = 0; i < 16; ++i) a[i] = x[i];
}
struct PairTab { int pi[64], pj[64], n; };
constexpr PairTab make_pairs() { PairTab t{}; int n = 0; for (int i = 0; i < 16; ++i) for (int j = 0; j < 16; ++j) if ((i + 1) * (j + 1) <= 16) { t.pi[n] = i; t.pj[n] = j; ++n; } t.n = n; for (int k = n; k < 64; ++k) { t.pi[k] = 0; t.pj[k] = 0; } return t; }
constexpr PairTab PAIRS = make_pairs();
static_assert(PAIRS.n == 50, "candidate pairs");
constexpr int KEY_PITCH = 272;
constexpr int LDS_KEYS = 0, LDS_LKP = 2 * NKEYS * KEY_PITCH;
#define TOPK_QLOAD(dst, qfrag_) do { _Pragma("unroll") for (int ks_ = 0; ks_ < 8; ++ks_) dst[ks_] = __builtin_nontemporal_load((const bf16x8*)((qfrag_) + ks_ * 512)); } while (0)
__device__ __forceinline__ void score_half_top16(Frame& F, const bf16x8 (&qf)[8], int half, int q32, int hi, unsigned (&top)[16]) {
    unsigned cur[16];
#pragma unroll
    for (int tl = 0; tl < 4; ++tl) {
        f32x16 S = {};
        const LAS unsigned char* kp = F.lds + LDS_KEYS + (half * NKEYS + tl * 32 + q32) * KEY_PITCH + hi * 16;
#pragma unroll
        for (int ks = 0; ks < 8; ++ks) { const bf16x8 kf = *(const LAS bf16x8*)(kp + ks * 32); S = __builtin_amdgcn_mfma_f32_32x32x16_bf16(kf, qf[ks], S, 0, 0, 0); }
        unsigned a[16];
#pragma unroll
        for (int r = 0; r < 16; ++r) a[r] = (f2sortable(S[r]) & ~127u) | (unsigned)(tl * 32 + crow(r, hi));
        sort16(a);
        if (tl == 0) {
#pragma unroll
            for (int i = 0; i < 16; ++i) cur[i] = a[i];
        } else merge16(cur, a);
    }
    merge_halves(cur);
#pragma unroll
    for (int i = 0; i < 16; ++i) top[i] = cur[i];
}
__device__ __forceinline__ void topk_stage_keys(Frame& F, const int h) {
    __syncthreads();
    for (int ch = F.tid; ch < 2 * NKEYS * 16; ch += NWAVES * 64) {
        const int hf = ch >> 11, key = (ch >> 4) & 127, cc = ch & 15;
        const v4u v = *(const GAS v4u*)(F.KEYSB + ((size_t)(hf * PEER_H + h) * NKEYS + key) * DHALF + cc * 8);
        *(LAS v4u*)(F.lds + LDS_KEYS + (hf * NKEYS + key) * KEY_PITCH + cc * 16) = v;
    }
}
__device__ __forceinline__ void topk_phase(Frame& F, const bool staged) {
    const int lane = F.lane, q32 = lane & 31, hi = lane >> 5;
    LAS unsigned* lkp = (LAS unsigned*)(F.lds + LDS_LKP + F.wave * 2048) + lane * 8;
    LAS unsigned char* lkpb = (LAS unsigned char*)lkp;
    constexpr int TOKB = 1024, NUNIT = (M / TOKB) * PEER_H;
    for (int unit = F.vcu; unit < NUNIT; unit += F.G) {
        const int h = unit & 7, sb = unit >> 3;
        if (!(staged && unit == F.vcu)) topk_stage_keys(F, h);
        __syncthreads();
        constexpr int NBLK = TOKB / 32 / NWAVES;
#define TOPK_QFRAG(blk_) (F.QP + ((((size_t)((sb * TOKB + ((blk_) * NWAVES + F.wave) * 32) >> 5) * PEER_H + h) * 2) * 16 * 32 + hi * 32 + q32) * 8)
        bf16x8 qa[8], qb[8];
        TOPK_QLOAD(qa, TOPK_QFRAG(0));
        for (int blk = 0; blk < NBLK; ++blk) {
            const int tok = sb * TOKB + (blk * NWAVES + F.wave) * 32 + q32;
            const bf16* qfrag = TOPK_QFRAG(blk);
            unsigned t1[16], t2[16];
            TOPK_QLOAD(qb, qfrag + 16 * 32 * 8);
            score_half_top16(F, qa, 0, q32, hi, t1);
            { const int bn = blk + 1 < NBLK ? blk + 1 : blk; TOPK_QLOAD(qa, TOPK_QFRAG(bn)); }
            score_half_top16(F, qb, 1, q32, hi, t2);
#pragma unroll
            for (int i = 0; i < 4; ++i) {
                lkp[i] = (t1[4 * i] & 127u) | ((t1[4 * i + 1] & 127u) << 8) | ((t1[4 * i + 2] & 127u) << 16) | ((t1[4 * i + 3] & 127u) << 24);
                lkp[4 + i] = (t2[4 * i] & 127u) | ((t2[4 * i + 1] & 127u) << 8) | ((t2[4 * i + 2] & 127u) << 16) | ((t2[4 * i + 3] & 127u) << 24);
            }
            float v1[16], v2[16];
#pragma unroll
            for (int i = 0; i < 16; ++i) { v1[i] = sortable2f(t1[i] & ~127u); v2[i] = sortable2f(t2[i] & ~127u); }
            unsigned best[16];
#pragma unroll
            for (int g = 0; g < 4; ++g) {
                unsigned cnd[16];
#pragma unroll
                for (int e = 0; e < 16; ++e) { const int k = g * 16 + e;
                    if (k < PAIRS.n) cnd[e] = (f2sortable(v1[PAIRS.pi[k]] + v2[PAIRS.pj[k]]) & ~255u) | (unsigned)(PAIRS.pi[k] * 16 + (15 - PAIRS.pj[k])); else cnd[e] = 0u; }
                if (g != 0) sort16(cnd);
                if (g == 0) {
#pragma unroll
                    for (int i = 0; i < 16; ++i) best[i] = cnd[i];
                } else merge16(best, cnd);
            }
            LDS_WAIT();
            float bv[16]; int ex[16];
#pragma unroll
            for (int k = 0; k < 16; ++k) { const unsigned code = best[k] & 255u; bv[k] = sortable2f(best[k] & ~255u);
                const int i1 = lkpb[code >> 4], i2 = lkpb[16 + (15u - (code & 15u))]; ex[k] = i1 * NKEYS + i2; }
            float ssum = 0.f; const float bmax = bv[0];
#pragma unroll
            for (int k = 0; k < 16; ++k) { bv[k] = __expf(bv[k] - bmax); ssum += bv[k]; }
            const float rs = 1.0f / ssum;
            const size_t o = ((size_t)tok * PEER_H + h) * TOPK;
            if (hi == 0) {
#pragma unroll
                for (int k4 = 0; k4 < 4; ++k4) { v4u w;
#pragma unroll
                    for (int i = 0; i < 4; ++i) w[i] = (unsigned)ex[4 * k4 + i] | (cvtpk(0.f, bv[4 * k4 + i] * rs) & 0xffff0000u);
                    *(GAS v4u*)(F.IG + o + 4 * k4) = w; }
            }
            LDS_WAIT();
        }
    }
}

__device__ __forceinline__ float gelu_tanh(float x) {
    const float y = 0.7978845608028654f * (x + 0.044715f * x * x * x);
    const float e = __expf(2.0f * y);
    const float th = 1.0f - 2.0f / (1.0f + e);
    return 0.5f * x * (1.0f + th);
}
__device__ __forceinline__ void store_u32_uncounted(unsigned* p, unsigned v) { asm volatile("global_store_dword %0, %1, off" :: "v"(p), "v"(v) : "memory"); }
__device__ __forceinline__ void store_f32x2_uncounted(float* p, f32x2_t v) { asm volatile("global_store_dwordx2 %0, %1, off" :: "v"(p), "v"(v) : "memory"); }
template <int CTRL> __device__ __forceinline__ int dppi(int v) { return __builtin_amdgcn_update_dpp(0, v, CTRL, 0xf, 0xf, false); }
constexpr int DPP_ROR8 = 0x128, DPP_HMIRROR = 0x141, DPP_QX2 = 0x4e, DPP_QX1 = 0xb1;
template <int XM> __device__ __forceinline__ int swzx(int v) { return __builtin_amdgcn_ds_swizzle(v, 0x1f | (XM << 10)); }
template <int XM> __device__ __forceinline__ float swzxf(float v) { return __int_as_float(__builtin_amdgcn_ds_swizzle(__float_as_int(v), 0x1f | (XM << 10))); }
__device__ __forceinline__ void xq_phase(Frame& F) {
    const int gw = F.vcu * NWAVES + F.wave, NGW = F.G * NWAVES, lane = F.lane;
    if (gw >= M) return;
    float g2[16];
#pragma unroll
    for (int i = 0; i < 8; ++i) { g2[i] = F.ffn_g[8 * lane + i]; g2[8 + i] = F.ffn_g[512 + 8 * lane + i]; }
    float ssn = F.SSQ1[gw]; v4u wan = *(const GAS v4u*)(F.X1B + (size_t)gw * D + 8 * lane), wbn = *(const GAS v4u*)(F.X1B + (size_t)gw * D + 512 + 8 * lane);
    for (int tok = gw; tok < M; tok += NGW) {
        const float rinv1 = rsqrtf(ssn * (1.f / D) + EPS);
        const v4u wa = wan, wb = wbn;
        { const int tn = tok + NGW < M ? tok + NGW : tok; ssn = F.SSQ1[tn]; wan = *(const GAS v4u*)(F.X1B + (size_t)tn * D + 8 * lane); wbn = *(const GAS v4u*)(F.X1B + (size_t)tn * D + 512 + 8 * lane); }
        float xv[16];
#pragma unroll
        for (int i = 0; i < 4; ++i) { xv[2 * i] = bf_lo(wa[i]) * rinv1 * g2[2 * i]; xv[2 * i + 1] = bf_hi(wa[i]) * rinv1 * g2[2 * i + 1]; xv[8 + 2 * i] = bf_lo(wb[i]) * rinv1 * g2[8 + 2 * i]; xv[8 + 2 * i + 1] = bf_hi(wb[i]) * rinv1 * g2[8 + 2 * i + 1]; }
        v4u o;
#pragma unroll
        for (int j = 0; j < 4; ++j) { int pk = __builtin_amdgcn_cvt_pk_fp8_f32(xv[4 * j], xv[4 * j + 1], 0, false); pk = __builtin_amdgcn_cvt_pk_fp8_f32(xv[4 * j + 2], xv[4 * j + 3], pk, true); o[j] = (unsigned)pk; }
        { v2u oa; oa.x = o[0]; oa.y = o[1]; v2u ob; ob.x = o[2]; ob.y = o[3];
          *(GAS v2u*)(F.XQ + (size_t)tok * D + 8 * lane) = oa; *(GAS v2u*)(F.XQ + (size_t)tok * D + 512 + 8 * lane) = ob; }
    }
}
struct PeerMap { int slice, rank, nper; };
__device__ __forceinline__ PeerMap peer_map(Frame& F, const XcdBarrier& bar) {
    unsigned sum = 0u, mine = 0u; bool ok = true;
#pragma unroll
    for (unsigned j = 0; j < 8; ++j) { const unsigned c = xb_ld(&bar.bar[XB_XCNT(j)]); sum += c; ok = ok && (c > 0u); mine = (j == bar.x) ? c : mine; }
    ok = ok && (sum == (unsigned)F.G) && (bar.x < 8u);
    PeerMap pm;
    if (ok) { pm.slice = (int)bar.x; pm.rank = (int)F.MISC[10]; pm.nper = (int)mine; }
    else { pm.nper = F.G >> 3; pm.slice = F.vcu / pm.nper; pm.rank = F.vcu % pm.nper; }
    return pm;
}
__device__ __forceinline__ PeerMap peer_map_v(Frame& F, const XcdBarrier& bar) {
    unsigned c[8]; unsigned sum = 0u; bool ok = true;
#pragma unroll
    for (unsigned j = 0; j < 8; ++j) { c[j] = xb_ld(&bar.bar[XB_XCNT(j)]); sum += c[j]; ok = ok && (c[j] > 0u); }
    ok = ok && (sum == (unsigned)F.G) && (bar.x < 8u);
    PeerMap pm;
    if (ok) { const unsigned x = bar.x, lo = x & 3u; unsigned clo = 0u, chi = 0u;
#pragma unroll
        for (unsigned j = 0; j < 4; ++j) { clo = (j == lo) ? c[j] : clo; chi = (j == lo) ? c[j + 4] : chi; }
        pm.slice = (int)lo; pm.rank = (int)F.MISC[10] + (x >= 4u ? (int)clo : 0); pm.nper = (int)(clo + chi); }
    else { const int nper = F.G >> 3, sl = F.vcu / nper; pm.slice = sl & 3; pm.rank = F.vcu % nper + (sl >> 2) * nper; pm.nper = 2 * nper; }
    return pm;
}
template <int VAR> __device__ __forceinline__ void u2_issue16(__amdgpu_buffer_rsrc_t urs, unsigned e10, int pass, int n, unsigned lane16, v4u (&rw)[16]) {
    const int nv = n - 16 * pass;
#pragma unroll
    for (int g = 0; g < 4; ++g) {
        if (g == 0 || 4 * g < nv) {
#pragma unroll
            for (int jj = 0; jj < 4; ++jj) { const int j = 4 * g + jj;
                const unsigned ro = (unsigned)__builtin_amdgcn_readlane((int)e10, 16 * pass + j);
                rw[j] = __builtin_bit_cast(v4u, __builtin_amdgcn_raw_buffer_load_b128(urs, (int)((VAR == 1 ? (ro & 0x7fe0fc00u) : ro) + lane16), 0, 0)); }
        }
    }
}
__device__ __forceinline__ int u2_dot16(const v4u (&rw)[16], const v4u xq, int lane) {
    const bool b3 = (lane & 8) != 0, b2 = (lane & 4) != 0, b1 = (lane & 2) != 0, b0 = (lane & 1) != 0;
    const int qx0 = (int)xq.x, qx1 = (int)xq.y, qx2 = (int)xq.z, qx3 = (int)xq.w;
    int p[16];
#pragma unroll
    for (int j = 0; j < 16; ++j) { const v4u r = rw[j]; int a = __builtin_amdgcn_sdot4((int)r.x, qx0, 0, false); a = __builtin_amdgcn_sdot4((int)r.y, qx1, a, false);
        a = __builtin_amdgcn_sdot4((int)r.z, qx2, a, false); p[j] = __builtin_amdgcn_sdot4((int)r.w, qx3, a, false); }
    int a8[8];
#pragma unroll
    for (int j = 0; j < 8; ++j) a8[j] = (b3 ? p[j + 8] : p[j]) + dppi<DPP_ROR8>(b3 ? p[j] : p[j + 8]);
    int a4[4];
#pragma unroll
    for (int j = 0; j < 4; ++j) a4[j] = (b2 ? a8[j + 4] : a8[j]) + dppi<DPP_HMIRROR>(b2 ? a8[j] : a8[j + 4]);
    int a2[2];
#pragma unroll
    for (int j = 0; j < 2; ++j) a2[j] = (b1 ? a4[j + 2] : a4[j]) + dppi<DPP_QX2>(b1 ? a4[j] : a4[j + 2]);
    int q = (b0 ? a2[1] : a2[0]) + dppi<DPP_QX1>(b0 ? a2[0] : a2[1]);
    q += swzx<16>(q);
    { auto rr = __builtin_amdgcn_permlane32_swap((unsigned)q, (unsigned)q, false, false); q = (int)rr[0] + (int)rr[1]; }
    return q;
}
struct U2Tok { unsigned ent, e10, r0, r1; int n, start; v4u xq; float xs, xsr, su, sv; };
template <int VAR> __device__ __forceinline__ void peer_u_phase(Frame& F, const PeerMap pm) {
    unsigned* const Wd = VAR ? (unsigned*)F.MIX : F.WP;
    const int lane = F.lane, nper = pm.nper, slice = pm.slice, rank = pm.rank;
    const int wi = rank * NWAVES + F.wave, NW = nper * NWAVES;
    const unsigned dummy = (unsigned)(slice << 11), lane16 = 16u * (unsigned)lane;
    LAS unsigned char* const sulds = F.lds + RING_OFF;
    for (int i = F.tid; i < 2048; i += NWAVES * 64) *(LAS f32x2_t*)(sulds + 8 * i) = *(const GAS f32x2_t*)(F.SU + 2 * ((size_t)slice * 2048 + i));
    __syncthreads();
    if (wi >= M) return;
    const __amdgpu_buffer_rsrc_t urs = __builtin_amdgcn_make_buffer_rsrc((void*)F.UQ, (short)0, NEXP * D, 0x00020000);
#define UTOK(t) ((t) < M ? (t) : wi)
    LAS unsigned* const slots = (LAS unsigned*)(F.lds + RING_OFF + 16384 + F.wave * 1024);
#define ULOAD(T, t) do { T.xq = *(const GAS v4u*)(F.XQ + (size_t)(t) * D + 16 * lane);   \
        T.r0 = F.IG[(size_t)(t) * NSEL + lane]; T.r1 = F.IG[(size_t)(t) * NSEL + 64 + lane]; T.xsr = F.XS[(t)]; } while (0)
#define UFIX(T, sl_) do { const int s0_ = (int)((T.r0 & 0xffffu) >> 11), s1_ = (int)((T.r1 & 0xffffu) >> 11); \
        const unsigned long long b0_ = __ballot(s0_ == slice), b1_ = __ballot(s1_ == slice); \
        const int n0_ = __builtin_popcountll(b0_); T.n = n0_ + __builtin_popcountll(b1_); \
        T.start = __builtin_popcountll(__ballot(s0_ < slice)) + __builtin_popcountll(__ballot(s1_ < slice)); \
        LAS unsigned* const q_ = slots + 128 * (sl_); \
        if (s0_ == slice) q_[__builtin_amdgcn_mbcnt_hi((unsigned)(b0_ >> 32), __builtin_amdgcn_mbcnt_lo((unsigned)b0_, 0u))] = T.r0; \
        if (s1_ == slice) q_[n0_ + (int)__builtin_amdgcn_mbcnt_hi((unsigned)(b1_ >> 32), __builtin_amdgcn_mbcnt_lo((unsigned)b1_, 0u))] = T.r1; \
        asm volatile("" ::: "memory"); T.ent = q_[lane]; T.xs = __uint_as_float((unsigned)__builtin_amdgcn_readfirstlane((int)__float_as_uint(T.xsr))); \
        if (lane >= T.n) T.ent = dummy; T.su = 0.f; T.sv = 0.f; if (lane < T.n) { const unsigned e_ = T.ent & 0x7ffu; const f32x2_t sc_ = *(const LAS f32x2_t*)(sulds + 8 * e_); T.su = sc_.x; T.sv = sc_.y; } \
        T.e10 = lane < T.n ? (T.ent & 0xffffu) << 10 : 0x7f000000u; } while (0)
    U2Tok C, N; int par = 0;
    v4u bufA[16], bufB[16];
    ULOAD(C, wi); UFIX(C, 0);
    u2_issue16<VAR>(urs, C.e10, 0, C.n, lane16, bufA);
    if (C.n > 16) u2_issue16<VAR>(urs, C.e10, 1, C.n, lane16, bufB);
    for (int tok = wi; tok < M; tok += NW) {
        const int tn = UTOK(tok + NW);
        ULOAD(N, tn);
        int d = 0;
        { const int q = u2_dot16(bufA, C.xq, lane); d = (lane < 16) ? q : d; }
        par ^= 1; UFIX(N, par);
        u2_issue16<VAR>(urs, N.e10, 0, N.n, lane16, bufA);
        if (C.n > 16) {
            { const int q = u2_dot16(bufB, C.xq, lane); d = ((lane >> 4) == 1) ? q : d; }
            if (C.n > 32) { u2_issue16<VAR>(urs, C.e10, 2, C.n, lane16, bufB); const int q = u2_dot16(bufB, C.xq, lane); d = ((lane >> 4) == 2) ? q : d; }
            if (C.n > 48) { u2_issue16<VAR>(urs, C.e10, 3, C.n, lane16, bufB); const int q = u2_dot16(bufB, C.xq, lane); d = ((lane >> 4) == 3) ? q : d; }
        }
        if (lane < C.n) { const float act = C.su * C.xs * (float)d; const float g = __uint_as_float(C.ent & 0xffff0000u);
            store_u32_uncounted(Wd + (size_t)tok * NSEL + C.start + lane, ((unsigned)__builtin_bit_cast(unsigned short, (_Float16)(256.f * g * gelu_tanh(act) * C.sv)) << 16) | (C.ent & 0xffffu)); }
        for (int c0 = 64; c0 < C.n; c0 += 64) {
            const int nn = C.n - c0;
            unsigned ent = slots[128 * (par ^ 1) + c0 + (lane < nn ? lane : 0)]; if (lane >= nn) ent = dummy;
            float su = 0.f, sv = 0.f; if (lane < nn) { const f32x2_t sc_ = *(const LAS f32x2_t*)(sulds + 8 * (ent & 0x7ffu)); su = sc_.x; sv = sc_.y; }
            int d2 = 0;
            for (int ps = 0; ps < 4; ++ps) { if (16 * ps < nn) {
#pragma unroll
                for (int j = 0; j < 16; ++j) { const unsigned e = (unsigned)__builtin_amdgcn_readlane((int)ent, (16 * ps + j) & 63) & 0xffffu; const unsigned loff = (16 * ps + j < nn) ? lane16 : 0u;
                    bufB[j] = *(const GAS v4u*)(F.UQ + ((size_t)e << 10) + loff); }
                const int q = u2_dot16(bufB, C.xq, lane); d2 = ((lane >> 4) == ps) ? q : d2; } }
            if (lane < nn) { const float act = su * C.xs * (float)d2; const float g = __uint_as_float(ent & 0xffff0000u);
                Wd[(size_t)tok * NSEL + C.start + c0 + lane] = ((unsigned)__builtin_bit_cast(unsigned short, (_Float16)(256.f * g * gelu_tanh(act) * sv)) << 16) | (ent & 0xffffu); }
        }
        if (N.n > 16) u2_issue16<VAR>(urs, N.e10, 1, N.n, lane16, bufB);
        C = N;
    }
#undef UTOK
#undef ULOAD
#undef UFIX
}
typedef int v8i_t __attribute__((ext_vector_type(8)));
typedef int v2i_t __attribute__((ext_vector_type(2)));
constexpr int VIMG_PITCH = 144;
#define LDS_RD128(dst, addr, off) asm volatile("ds_read_b128 %0, %1 offset:%2" : "=v"(dst) : "v"(addr), "n"(off) : "memory")
#define LDS_TR64(dst, addr, off) asm volatile("ds_read_b64_tr_b4 %0, %1 offset:%2" : "=v"(dst) : "v"(addr), "n"(off) : "memory")
template <int VAR> __device__ __forceinline__ void v_dma_half(const __amdgpu_buffer_rsrc_t vrs, LAS unsigned char* imgh, const unsigned g0, const unsigned g1, const v4u (&e)[2], const int h) {
#pragma unroll
    for (int jj = 0; jj < 8; ++jj) { const int j = 8 * h + jj; const unsigned w = e[j >> 3][(j >> 1) & 3]; const unsigned ex = ((j & 1) ? (w >> 16) : (w & 0xffffu)) & (VAR == 1 ? 0x3ffu : 0xffffu);
        __builtin_amdgcn_raw_ptr_buffer_load_lds(vrs, (LAS void*)(imgh + 1024 * jj), 16, (int)((ex << 7) + ((j & 1) ? g1 : g0)), 0, 0, 0); }
}
template <int H> __device__ __forceinline__ void v_rd_half(const unsigned (&ra)[4], v2i_t (&t)[16]) {
#pragma unroll
    for (int q = 0; q < 4; ++q) { LDS_TR64(t[4 * q + 0], ra[q], 8192 * H); LDS_TR64(t[4 * q + 1], ra[q], 8192 * H + 2048); LDS_TR64(t[4 * q + 2], ra[q], 8192 * H + 8); LDS_TR64(t[4 * q + 3], ra[q], 8192 * H + 2056); }
    asm volatile("s_waitcnt lgkmcnt(0)" : "+v"(t[0]), "+v"(t[1]), "+v"(t[2]), "+v"(t[3]), "+v"(t[4]), "+v"(t[5]), "+v"(t[6]), "+v"(t[7]), "+v"(t[8]), "+v"(t[9]), "+v"(t[10]), "+v"(t[11]), "+v"(t[12]), "+v"(t[13]), "+v"(t[14]), "+v"(t[15]) :: "memory");
}
template <int H> __device__ __forceinline__ void v_mma_half(const v2i_t (&t)[16], const v8i_t W, f32x4 (&D)[8], const bool hi) {
    v8i_t Wh;
#pragma unroll
    for (int q = 0; q < 4; ++q) { const int wv = W[4 * H + q]; Wh[q] = hi ? 0 : wv; Wh[4 + q] = hi ? wv : 0; }
#pragma unroll
    for (int bq = 0; bq < 8; ++bq) {
        const v2i_t t0 = t[4 * (bq >> 1) + 2 * (bq & 1)], t1 = t[4 * (bq >> 1) + 2 * (bq & 1) + 1];
        const v8i_t A = {t0.x, t0.y, t1.x, t1.y, 0, 0, 0, 0};
        D[bq] = __builtin_amdgcn_mfma_scale_f32_16x16x128_f8f6f4(A, Wh, D[bq], 4  , 0  , 0, 0x7f7f7f7f, 0, 0x7f7f7f7f);
        asm volatile("" : "+v"(D[bq]));
    }
}
template <int VAR> __device__ __forceinline__ void peer_v_phase(Frame& F, const PeerMap pm) {
    const int lane = F.lane, nper = pm.nper, slice = pm.slice, rank = pm.rank;
    const int wi = rank * NWAVES + F.wave, NW = nper * NWAVES, rg = lane >> 3, ch = lane & 7, n = lane & 15, kb = lane >> 4;
    const unsigned long long vbase_ = (unsigned long long)(F.VQ + (size_t)slice * NEXP * 128);
    const unsigned long long vbase = ((unsigned long long)(unsigned)__builtin_amdgcn_readfirstlane((int)(vbase_ >> 32)) << 32) | (unsigned)__builtin_amdgcn_readfirstlane((int)(unsigned)vbase_);
    const __amdgpu_buffer_rsrc_t vrs = __builtin_amdgcn_make_buffer_rsrc((void*)vbase, (short)0, NEXP * 128, 0x00020000);
    const unsigned g0 = 16u * (unsigned)(ch ^ (rg >> 1)), g1 = 16u * (unsigned)(ch ^ (4 | (rg >> 1)));
    const int col = slice * 256 + 16 * (lane & 15) + 4 * (lane >> 4);
    const int wv_ = __builtin_amdgcn_readfirstlane(F.wave);
    LAS unsigned char* const img = F.lds + RING_OFF + wv_ * 16384;
    LAS unsigned char* const e16 = F.lds + LDSCTL_OFF + 1024 + wv_ * 768;
    LAS unsigned char* const w8 = e16 + 512;
    if (wi >= M) return;
    float* const dummy = (float*)((unsigned char*)F.MIX + 16 * MiB);
    const bool hi = n >= 8;
    unsigned ra[4];
    { const int sw = (n >> 1) & 7;
#pragma unroll
      for (int q = 0; q < 4; ++q) ra[q] = (unsigned)(size_t)(img + (32 * (kb & 1) + n) * 128 + 16 * ((q ^ (sw & 3)) | ((4 * (kb >> 1)) ^ (sw & 4)))); }
    const unsigned e16rd = (unsigned)(size_t)(e16 + 32 * rg), w8rd = (unsigned)(size_t)(w8 + 16 * kb);
#define VTOK(t) ((t) < M ? (t) : wi)
    v4u eN[2]; v2u xC; v2u mg; v8i_t Wc;
#define VX1(t) (*(const GAS v2u*)(F.X1B + (size_t)(t) * D + col))
#define VOUT(t) ((v2u*)(VAR ? (bf16*)dummy + (size_t)((t) & 1023) * D + col : F.X2B + (size_t)(t) * D + col))
#define VMG(t) (*(const GAS v2u*)(F.WP + (size_t)(t) * NSEL + 2 * lane))
#define LDS_WR16(addr, val, off) asm volatile("ds_write_b16 %0, %1 offset:%2" :: "v"(addr), "v"(val), "n"(off) : "memory")
    const unsigned e16wr = (unsigned)(size_t)(e16 + 64 * (lane & 3) + 2 * (lane >> 2)), w8wr = (unsigned)(size_t)(w8 + 2 * lane);
#define VMPUT(slot, v) do { const unsigned v0_ = (v).x, v1_ = (v).y; const unsigned qa_ = e16wr + ((unsigned)(slot) << 8), qw_ = w8wr + ((unsigned)(slot) << 7); \
        LDS_WR16(qa_, v0_, 0); LDS_WR16(qa_, v1_, 32); \
        const float f0_ = __builtin_amdgcn_fmed3f((float)__builtin_bit_cast(_Float16, (unsigned short)(v0_ >> 16)), -448.f, 448.f), f1_ = __builtin_amdgcn_fmed3f((float)__builtin_bit_cast(_Float16, (unsigned short)(v1_ >> 16)), -448.f, 448.f);   \
        const unsigned pk_ = (unsigned)__builtin_amdgcn_cvt_pk_fp8_f32(f0_, f1_, 0, false); LDS_WR16(qw_, pk_, 0); } while (0)
#define VMGET(slot, m) do { const unsigned qa_ = e16rd + ((unsigned)(slot) << 8); LDS_RD128(m[0], qa_, 0); LDS_RD128(m[1], qa_, 16); } while (0)
#define VWGET(slot, a_, b_) do { const unsigned qw_ = w8rd + ((unsigned)(slot) << 7); LDS_RD128(a_, qw_, 0); LDS_RD128(b_, qw_, 64); } while (0)
    mg = VMG(wi); VMPUT(0, mg); VMGET(0, eN);
    asm volatile("s_waitcnt lgkmcnt(0)" : "+v"(eN[0]), "+v"(eN[1]) :: "memory");
    mg = VMG(VTOK(wi + NW)); VMPUT(1, mg);
    mg = VMG(VTOK(wi + 2 * NW));
    v_dma_half<VAR>(vrs, img, g0, g1, eN, 0); v_dma_half<VAR>(vrs, img + 8192, g0, g1, eN, 1);
    int s_ = 0;
    for (int tok = wi; tok < M; tok += NW, s_ ^= 1) {
        v4u wa, wb;
        VWGET(s_, wa, wb);
        VMGET(s_ ^ 1, eN);
        asm volatile("s_waitcnt lgkmcnt(0)" : "+v"(wa), "+v"(wb), "+v"(eN[0]), "+v"(eN[1]) :: "memory");
        Wc = (v8i_t){(int)wa.x, (int)wa.y, (int)wa.z, (int)wa.w, (int)wb.x, (int)wb.y, (int)wb.z, (int)wb.w};
        xC = VX1(tok);
        VMPUT(s_, mg);
        mg = VMG(VTOK(tok + 3 * NW));
        f32x4 Dm[8];
#pragma unroll
        for (int bq = 0; bq < 8; ++bq) Dm[bq] = (f32x4){0.f, 0.f, 0.f, 0.f};
        __builtin_amdgcn_sched_barrier(0);
        asm volatile("s_waitcnt vmcnt(10)" ::: "memory");
        __builtin_amdgcn_sched_barrier(0);
        v2i_t tr_[16];
        v_rd_half<0>(ra, tr_);
        __builtin_amdgcn_sched_barrier(0);
        v_dma_half<VAR>(vrs, img, g0, g1, eN, 0);
        __builtin_amdgcn_sched_barrier(0);
        v_mma_half<0>(tr_, Wc, Dm, hi);
        __builtin_amdgcn_sched_barrier(0);
        asm volatile("s_waitcnt vmcnt(10)" ::: "memory");
        __builtin_amdgcn_sched_barrier(0);
        v_rd_half<1>(ra, tr_);
        __builtin_amdgcn_sched_barrier(0);
        v_dma_half<VAR>(vrs, img + 8192, g0, g1, eN, 1);
        __builtin_amdgcn_sched_barrier(0);
        v_mma_half<1>(tr_, Wc, Dm, hi);
        __builtin_amdgcn_sched_barrier(0);
        float o[4];
#pragma unroll
        for (int j = 0; j < 4; ++j) { float v = Dm[0][j];
#pragma unroll
            for (int bb = 1; bb < 8; ++bb) v = ((n & 7) == bb) ? Dm[bb][j] : v;
            o[j] = v * 0.00390625f; }
        v2u w; w.x = cvtpk(bf_lo(xC.x) + o[0], bf_hi(xC.x) + o[1]); w.y = cvtpk(bf_lo(xC.y) + o[2], bf_hi(xC.y) + o[3]);
        v2u* const xo = VOUT(tok);
        asm volatile("global_store_dwordx2 %0, %1, off" :: "v"(xo), "v"(w) : "memory");
    }
    asm volatile("s_waitcnt vmcnt(0)" ::: "memory");
#undef VMG
#undef VMPUT
#undef VMGET
#undef VWGET
#undef LDS_WR16
#undef VX1
#undef VOUT
#undef VTOK
}
template <int H> __device__ __forceinline__ void u_rd_half(const unsigned (&rb)[2], v4u (&t)[8]) {
#pragma unroll
    for (int gg = 0; gg < 4; ++gg) { LDS_RD128(t[2 * gg], rb[0], 8192 * H + 2048 * gg); LDS_RD128(t[2 * gg + 1], rb[1], 8192 * H + 2048 * gg); }
    asm volatile("s_waitcnt lgkmcnt(0)" : "+v"(t[0]), "+v"(t[1]), "+v"(t[2]), "+v"(t[3]), "+v"(t[4]), "+v"(t[5]), "+v"(t[6]), "+v"(t[7]) :: "memory");
}
template <int H> __device__ __forceinline__ void u_mma_half(const v4u (&t)[8], const v8i_t (&A)[2], f32x4 (&D)[8]) {
#pragma unroll
    for (int gg = 0; gg < 4; ++gg) {
#pragma unroll
        for (int st = 0; st < 2; ++st) { const v4u tt = t[2 * gg + st]; const v8i_t B = {(int)tt.x, (int)tt.y, (int)tt.z, (int)tt.w, 0, 0, 0, 0};
            D[4 * H + gg] = __builtin_amdgcn_mfma_scale_f32_16x16x128_f8f6f4(A[st], B, D[4 * H + gg], 0  , 4  , 0, 0x7f7f7f7f, 0, 0x7f7f7f7f); }
        asm volatile("" : "+v"(D[4 * H + gg]));
    }
}
__device__ __forceinline__ void peer_u4_phase(Frame& F, const PeerMap pm) {
    const int lane = F.lane, nper = pm.nper, slice = pm.slice, rank = pm.rank;
    const int wi = rank * NWAVES + F.wave, NW = nper * NWAVES, rg = lane >> 3, ch = lane & 7, n = lane & 15, kb = lane >> 4;
    const unsigned long long ubase_ = (unsigned long long)(F.UQ + (size_t)slice * NEXP * 128);
    const unsigned long long ubase = ((unsigned long long)(unsigned)__builtin_amdgcn_readfirstlane((int)(ubase_ >> 32)) << 32) | (unsigned)__builtin_amdgcn_readfirstlane((int)(unsigned)ubase_);
    const __amdgpu_buffer_rsrc_t urs = __builtin_amdgcn_make_buffer_rsrc((void*)ubase, (short)0, NEXP * 128, 0x00020000);
    const unsigned g0 = 16u * (unsigned)(ch ^ (rg >> 1)), g1 = 16u * (unsigned)(ch ^ (4 | (rg >> 1)));
    const int wv_ = __builtin_amdgcn_readfirstlane(F.wave);
    LAS unsigned char* const img = F.lds + RING_OFF + wv_ * 16384;
    LAS unsigned char* const e16 = F.lds + LDSCTL_OFF + 1024 + wv_ * 768;
    if (wi >= M) return;
    float* const PD = (float*)F.MIX + (size_t)slice * M * (NSEL / 2);
    unsigned rb[2];
#pragma unroll
    for (int st = 0; st < 2; ++st) rb[st] = (unsigned)(size_t)(img + 128 * n + 16 * ((4 * st + kb) ^ (n >> 1)));
    const unsigned e16rd = (unsigned)(size_t)(e16 + 32 * rg);
    const unsigned e16wr = (unsigned)(size_t)(e16 + 64 * (lane & 3) + 2 * (lane >> 2));
#define UTOK(t) ((t) < M ? (t) : wi)
#define LDS_WR16(addr, val, off) asm volatile("ds_write_b16 %0, %1 offset:%2" :: "v"(addr), "v"(val), "n"(off) : "memory")
#define UMG(t) (*(const GAS v2u*)(F.IG + (size_t)(t) * NSEL + 2 * lane))
#define UMPUT(slot, v) do { const unsigned v0_ = (v).x, v1_ = (v).y; const unsigned qa_ = e16wr + ((unsigned)(slot) << 8); LDS_WR16(qa_, v0_, 0); LDS_WR16(qa_, v1_, 32); } while (0)
#define UMGET(slot, m) do { const unsigned qa_ = e16rd + ((unsigned)(slot) << 8); LDS_RD128(m[0], qa_, 0); LDS_RD128(m[1], qa_, 16); } while (0)
#define UXL(t) (*(const GAS v4u*)(F.XQ + (size_t)(t) * D + slice * 256 + 16 * (kb + 4 * (n & 3))))
#define UBC(x_, m_) ((int)__builtin_amdgcn_update_dpp(0, (int)(x_), 0x150 + (m_), 0xf, 0xf, false))
#define UXA(A_, xl_) do { const unsigned x0_ = (xl_).x, x1_ = (xl_).y, x2_ = (xl_).z, x3_ = (xl_).w; \
        A_[0] = (v8i_t){UBC(x0_, 0), UBC(x1_, 0), UBC(x2_, 0), UBC(x3_, 0), UBC(x0_, 1), UBC(x1_, 1), UBC(x2_, 1), UBC(x3_, 1)}; \
        A_[1] = (v8i_t){UBC(x0_, 2), UBC(x1_, 2), UBC(x2_, 2), UBC(x3_, 2), UBC(x0_, 3), UBC(x1_, 3), UBC(x2_, 3), UBC(x3_, 3)}; } while (0)
    v4u eN[2]; v2u mg; v8i_t Ac[2]; v4u xln;
    mg = UMG(wi); UMPUT(0, mg); UMGET(0, eN);
    asm volatile("s_waitcnt lgkmcnt(0)" : "+v"(eN[0]), "+v"(eN[1]) :: "memory");
    mg = UMG(UTOK(wi + NW)); UMPUT(1, mg);
    xln = UXL(wi); UXA(Ac, xln);
    mg = UMG(UTOK(wi + 2 * NW));
    v_dma_half<0>(urs, img, g0, g1, eN, 0); v_dma_half<0>(urs, img + 8192, g0, g1, eN, 1);
    int s_ = 0;
    for (int tok = wi; tok < M; tok += NW, s_ ^= 1) {
        UMGET(s_ ^ 1, eN);
        asm volatile("s_waitcnt lgkmcnt(0)" : "+v"(eN[0]), "+v"(eN[1]) :: "memory");
        xln = UXL(UTOK(tok + NW));
        UMPUT(s_, mg);
        mg = UMG(UTOK(tok + 3 * NW));
        f32x4 Dm[8];
#pragma unroll
        for (int g = 0; g < 8; ++g) Dm[g] = (f32x4){0.f, 0.f, 0.f, 0.f};
        __builtin_amdgcn_sched_barrier(0);
        asm volatile("s_waitcnt vmcnt(10)" ::: "memory");
        __builtin_amdgcn_sched_barrier(0);
        v4u ur_[8];
        u_rd_half<0>(rb, ur_);
        __builtin_amdgcn_sched_barrier(0);
        v_dma_half<0>(urs, img, g0, g1, eN, 0);
        __builtin_amdgcn_sched_barrier(0);
        u_mma_half<0>(ur_, Ac, Dm);
        __builtin_amdgcn_sched_barrier(0);
        asm volatile("s_waitcnt vmcnt(10)" ::: "memory");
        __builtin_amdgcn_sched_barrier(0);
        u_rd_half<1>(rb, ur_);
        __builtin_amdgcn_sched_barrier(0);
        v_dma_half<0>(urs, img + 8192, g0, g1, eN, 1);
        __builtin_amdgcn_sched_barrier(0);
        u_mma_half<1>(ur_, Ac, Dm);
        __builtin_amdgcn_sched_barrier(0);
        f32x2_t pv;
        pv.x = kb == 0 ? Dm[0][0] : kb == 1 ? Dm[2][0] : kb == 2 ? Dm[4][0] : Dm[6][0];
        pv.y = kb == 0 ? Dm[1][0] : kb == 1 ? Dm[3][0] : kb == 2 ? Dm[5][0] : Dm[7][0];
        unsigned* const po = (unsigned*)PD + (size_t)tok * (NSEL / 2) + lane;
        const unsigned pk16 = (unsigned)__builtin_bit_cast(unsigned short, (_Float16)pv.x) | ((unsigned)__builtin_bit_cast(unsigned short, (_Float16)pv.y) << 16);
        asm volatile("global_store_dword %0, %1, off" :: "v"(po), "v"(pk16) : "memory");
        UXA(Ac, xln);
    }
    asm volatile("s_waitcnt vmcnt(0)" ::: "memory");
#undef UTOK
#undef LDS_WR16
#undef UMG
#undef UMPUT
#undef UMGET
#undef UXL
#undef UBC
#undef UXA
}
__device__ __forceinline__ void u_combine_fill(Frame& F) {
    __syncthreads();
    LAS unsigned char* const sulds = F.lds + RING_OFF;
    for (int i = F.tid; i < NEXP / 2; i += NWAVES * 64) *(LAS v4u*)(sulds + 16 * i) = *(const GAS v4u*)((const unsigned char*)F.SU + 16 * (size_t)i);
}
__device__ __forceinline__ void u_combine_phase(Frame& F) {
    const int gw = F.vcu * NWAVES + F.wave, NGW = F.G * NWAVES, lane = F.lane;
    LAS unsigned char* const sulds = F.lds + RING_OFF;
    __syncthreads();
    if (gw >= M) return;
    const int R0 = 32 * (lane >> 4) + (lane & 15);
    const float* const PD = (const float*)F.MIX;
#define UC_LOAD(t, ig0_, ig1_, p_) do { ig0_ = F.IG[(size_t)(t) * NSEL + R0]; ig1_ = F.IG[(size_t)(t) * NSEL + R0 + 16]; \
        _Pragma("unroll") for (int c_ = 0; c_ < 4; ++c_) { const unsigned w_ = *(const GAS unsigned*)((const unsigned*)PD + ((size_t)c_ * M + (t)) * (NSEL / 2) + lane); \
            p_[c_].x = (float)__builtin_bit_cast(_Float16, (unsigned short)(w_ & 0xffffu)); p_[c_].y = (float)__builtin_bit_cast(_Float16, (unsigned short)(w_ >> 16)); } } while (0)
    unsigned ia, ib, na, nb; f32x2_t pc[4], pn[4];
    UC_LOAD(gw, na, nb, pn);
    for (int tok = gw; tok < M; tok += NGW) {
        ia = na; ib = nb;
#pragma unroll
        for (int c = 0; c < 4; ++c) pc[c] = pn[c];
        const f32x2_t sa = *(const LAS f32x2_t*)(sulds + 8 * (ia & 0xffffu)), sb = *(const LAS f32x2_t*)(sulds + 8 * (ib & 0xffffu));
        { const int tn = tok + NGW < M ? tok + NGW : tok; UC_LOAD(tn, na, nb, pn); }
        const float d0 = (pc[0].x + pc[1].x) + (pc[2].x + pc[3].x), d1 = (pc[0].y + pc[1].y) + (pc[2].y + pc[3].y);
        const float ga = __uint_as_float(ia & 0xffff0000u), gb = __uint_as_float(ib & 0xffff0000u);
        v2u w;
        w.x = ((unsigned)__builtin_bit_cast(unsigned short, (_Float16)(256.f * ga * gelu_tanh(sa.x * d0) * sa.y)) << 16) | (ia & 0xffffu);
        w.y = ((unsigned)__builtin_bit_cast(unsigned short, (_Float16)(256.f * gb * gelu_tanh(sb.x * d1) * sb.y)) << 16) | (ib & 0xffffu);
        *(v2u*)(F.WP + (size_t)tok * NSEL + 2 * lane) = w;
    }
#undef UC_LOAD
}
__device__ __forceinline__ void final_phase(Frame& F) {
    const int gw = F.vcu * NWAVES + F.wave, NGW = F.G * NWAVES;
    const int lane = F.lane;
    const GAS f32x4* gr = (const GAS f32x4*)F.fin_g + lane;
    f32x4 gg[4];
#pragma unroll
    for (int j = 0; j < 4; ++j) gg[j] = gr[64 * j];
    for (int m = gw; m < M; m += 2 * NGW) {
        const bool ok1 = m + NGW < M; const int m1 = ok1 ? m + NGW : m;
        const GAS unsigned long long* a0 = (const GAS unsigned long long*)(F.X2B + (size_t)m * D) + lane; const GAS unsigned long long* a1 = (const GAS unsigned long long*)(F.X2B + (size_t)m1 * D) + lane;
        unsigned long long u[4], w[4];
#pragma unroll
        for (int j = 0; j < 4; ++j) { u[j] = a0[64 * j]; w[j] = a1[64 * j]; }
        f32x4 v[4], z[4]; float s = 0.f, t = 0.f;
#pragma unroll
        for (int j = 0; j < 4; ++j) { v[j].x = bf_lo((unsigned)u[j]); v[j].y = bf_hi((unsigned)u[j]); v[j].z = bf_lo((unsigned)(u[j] >> 32)); v[j].w = bf_hi((unsigned)(u[j] >> 32));
            z[j].x = bf_lo((unsigned)w[j]); z[j].y = bf_hi((unsigned)w[j]); z[j].z = bf_lo((unsigned)(w[j] >> 32)); z[j].w = bf_hi((unsigned)(w[j] >> 32));
            s += (v[j].x * v[j].x + v[j].y * v[j].y) + (v[j].z * v[j].z + v[j].w * v[j].w); t += (z[j].x * z[j].x + z[j].y * z[j].y) + (z[j].z * z[j].z + z[j].w * z[j].w); }
        const float r0 = rsqrtf(wave_sum(s) * (1.f / D) + EPS), r1 = rsqrtf(wave_sum(t) * (1.f / D) + EPS);
        GAS f32x4* o0 = (GAS f32x4*)(F.out + (size_t)m * D) + lane; GAS f32x4* o1 = (GAS f32x4*)(F.out + (size_t)m1 * D) + lane;
#pragma unroll
        for (int j = 0; j < 4; ++j) { f32x4 o; o.x = v[j].x * r0 * gg[j].x; o.y = v[j].y * r0 * gg[j].y; o.z = v[j].z * r0 * gg[j].z; o.w = v[j].w * r0 * gg[j].w; __builtin_nontemporal_store(o, o0 + 64 * j);
            if (ok1) { f32x4 p; p.x = z[j].x * r1 * gg[j].x; p.y = z[j].y * r1 * gg[j].y; p.z = z[j].z * r1 * gg[j].z; p.w = z[j].w * r1 * gg[j].w; __builtin_nontemporal_store(p, o1 + 64 * j); } }
    }
}

struct Args { const float* in[14]; float* out; unsigned char* ws; int ph_lo, ph_hi, li, pad; };
__global__ void __launch_bounds__(NWAVES * 64, 2) mk_fwd(Args args) {
    extern __shared__ __attribute__((aligned(16))) unsigned char lds[];
    Frame F;
    F.lds = (LAS unsigned char*)lds;
    F.MISC = (volatile LAS unsigned*)(F.lds + MISC_OFF);
    F.tid = threadIdx.x; F.lane = F.tid & 63; F.wave = __builtin_amdgcn_readfirstlane(F.tid >> 6);
    F.G = gridDim.x; { const int bx = blockIdx.x; F.vcu = (F.G % 8 == 0) ? (bx % 8) * (F.G / 8) + bx / 8 : bx; }
#define GRID_BAR(seam) do { if (N_LAUNCHES == PER_PHASE) { if (F.tid == 0) __hip_atomic_store(F.ctl + CW_TMO, 0xBADBA0u | (unsigned)(seam), RLX_AGENT); } \
    else { xcd_barrier(bar); } } while (0)
    unsigned char* ws = args.ws;
    F.ctl = (gu32*)(ws + WS_CTL);
    F.x = args.in[0]; F.mix_g = args.in[1]; F.w_in = args.in[2]; F.conv_w = args.in[3]; F.conv_b = args.in[4]; F.attn_g = args.in[5]; F.conv_g = args.in[6];
    F.w_out = args.in[7]; F.ffn_g = args.in[8]; F.wq = args.in[9]; F.keys = args.in[10]; F.pu = args.in[11]; F.pv = args.in[12]; F.fin_g = args.in[13];
    F.out = args.out;
    F.WinT = (bf16*)(ws + WS_WIN); F.WoutT = (bf16*)(ws + WS_WOUT); F.WqT = (bf16*)(ws + WS_WQ); F.KEYSB = (bf16*)(ws + WS_KEYS);
    F.UQ = ws + WS_UQ; F.VQ = ws + WS_VQ; F.SU = (float*)(ws + WS_SU); F.SV = (float*)(ws + WS_SV); F.XQ = ws + WS_XQ; F.X2B = (bf16*)(ws + WS_XN); F.X1B = (bf16*)(ws + WS_X1B); F.XS = (float*)(ws + WS_XS); F.XN = (bf16*)(ws + WS_XN);
    F.Q = (bf16*)(ws + WS_Q); F.K = F.Q + (size_t)M * HW; F.GB = F.K + (size_t)M * HW; F.UU = F.GB + (size_t)M * HW;
    F.VTR = (bf16*)(ws + WS_VTR); F.QP = (bf16*)(ws + WS_QP); F.MIX = (bf16*)(ws + WS_MIX);
    F.SSQ1 = (float*)(ws + WS_SSQ1); F.IG = (unsigned*)(ws + WS_IDX); F.IGS = (unsigned*)(ws + WS_GW); F.PFX = (unsigned*)(ws + WS_PFX); F.WP = (unsigned*)(ws + WS_W);
    for (int u = F.tid; u < (LDS_BYTES - LDSCTL_OFF) / 4; u += NWAVES * 64) ((LAS unsigned*)(F.lds + LDSCTL_OFF))[u] = 0u;
    __syncthreads();
    XcdBarrier bar; bar.bar = (unsigned*)(F.ctl + CW_BAR); bar.x = 0; bar.st = nullptr;
    if (N_LAUNCHES != PER_PHASE) { bar = xcd_barrier_post((unsigned*)(F.ctl + CW_BAR), F.MISC + 8);
        if (F.tid == 0) F.MISC[10] = __hip_atomic_fetch_add(F.ctl + CW_TICKET + 64 * bar.x, 1u, RLX_AGENT); }
    const int lo = args.ph_lo, hi = args.ph_hi;
#define IN(k) (lo <= (k) && (k) < hi)
#define REFRESH() do { int t_ = threadIdx.x; asm volatile("" : "+v"(t_)); F.tid = t_; F.lane = t_ & 63; F.wave = __builtin_amdgcn_readfirstlane(t_ >> 6); } while (0)
#ifndef MK_REP_PHASE
#define MK_REP_PHASE -1
#endif
#define REPS(k) ((k) == MK_REP_PHASE ? 2 : 1)


#define BOTH(k) (IN(k) && IN((k) + 1))

    if (IN(0)) { REFRESH(); for (int rep = 0; rep < REPS(0); ++rep) { p0_prologue<0>(F, F.vcu * NWAVES + F.wave, F.G * NWAVES); if (rep + 1 < REPS(0)) GRID_BAR(0); } if (BOTH(0)) GRID_BAR(0); }

    if (IN(1)) { for (int rep = 0; rep < REPS(1); ++rep) {
        { pg8::Gemm g{F.XN, F.WinT, M, 5 * HW, D}; pg8::StaticOrder S; S.init(M, 5 * HW, F.G, (int)blockIdx.x);
          pg8::EpiProj E{F.Q, (size_t)M * HW, QSCALE};
          pg8::gemm_phase<pg8::EpiProj, pg8::StaticOrder, PG8_ALIGN, PG8_SP2>(F.lds + RING_OFF, g, S, E); }
        { pg8::Gemm g{F.WinT + (size_t)5 * HW * D, F.XN, HW, M, D}; pg8::StaticOrder S; S.init(HW, M, F.G, (int)blockIdx.x);
          pg8::EpiVT E{F.VTR};
          pg8::gemm_phase<pg8::EpiVT, pg8::StaticOrder, PG8_ALIGN, PG8_SP2>(F.lds + RING_OFF, g, S, E); }
        if (rep + 1 < REPS(1)) GRID_BAR(1); }
        if (BOTH(1)) GRID_BAR(1);
    }

    if (IN(2)) { REFRESH(); for (int rep = 0; rep < REPS(2); ++rep) {
        if (F.tid == 0) *(volatile LAS unsigned*)(F.lds + RING_OFF + 2048) = 0u;
        __syncthreads();
        if (F.wave < ATT_WAVES) { attn_phase(F); p0_quant_rows(F, F.vcu * ATT_WAVES + F.wave, F.G * ATT_WAVES, Q_SPLIT, 2 * NEXP); }
        else { const int sgw = F.vcu * (NWAVES - ATT_WAVES) + (F.wave - ATT_WAVES), SNGW = F.G * (NWAVES - ATT_WAVES); conv_phase(F, sgw, SNGW); p0_prologue<1>(F, sgw, SNGW); }
        if (rep + 1 < REPS(2)) GRID_BAR(2); } if (BOTH(2)) GRID_BAR(2); }

    if (IN(3)) {
        pg8::Gemm g{F.MIX, F.WoutT, M, D, D}; pg8::StaticOrder S; S.init(M, D, F.G, (int)blockIdx.x);
        pg8::EpiResid E{F.x, F.X1B, F.SSQ1, D};
        pg8::gemm_phase<pg8::EpiResid, pg8::StaticOrder, PG8_ALIGN, PG8_SP2>(F.lds + RING_OFF, g, S, E);
        if (BOTH(3)) GRID_BAR(3);
    }

    if (IN(4)) {
        pg8::Gemm g{F.X1B, F.WqT, M, PEER_H * PEER_DK, D}; pg8::StaticOrder S; S.init(M, PEER_H * PEER_DK, F.G, (int)blockIdx.x);
        pg8::EpiBf16Rs E{F.QP, PEER_H * PEER_DK, F.SSQ1, 1.f / D, EPS};
        pg8::gemm_phase<pg8::EpiBf16Rs, pg8::StaticOrder, PG8_ALIGN, PG8_SP2>(F.lds + RING_OFF, g, S, E);
#ifdef MK_GEMM4X2
        GRID_BAR(4); pg8::gemm_phase<pg8::EpiBf16Rs, pg8::StaticOrder, PG8_ALIGN, PG8_SP2>(F.lds + RING_OFF, g, S, E);
#endif
        if (BOTH(4)) { REFRESH(); if (F.vcu < (M / 1024) * PEER_H) topk_stage_keys(F, F.vcu & 7); GRID_BAR(4); }
    }

    if (IN(5)) { REFRESH(); for (int rep = 0; rep < REPS(5); ++rep) { topk_phase(F, IN(4) && rep == 0); xq_phase(F); if (rep + 1 < REPS(5)) GRID_BAR(5); } if (BOTH(5)) GRID_BAR(5); }


    if (IN(7)) { REFRESH(); peer_u4_phase(F, peer_map_v(F, bar)); u_combine_fill(F); GRID_BAR(7); u_combine_phase(F);
        if (BOTH(7)) GRID_BAR(7); }

    if (IN(8)) { REFRESH();
#ifdef MK_VVAR
        peer_v_phase<MK_VVAR>(F, peer_map_v(F, bar)); GRID_BAR(8);
#endif
        peer_v_phase<0>(F, peer_map_v(F, bar)); if (BOTH(8)) GRID_BAR(8); }

    if (IN(9)) { REFRESH(); final_phase(F); }
#undef IN
#undef BOTH
}

extern "C" void kernel_launch(void* const* d_in, const int* in_sizes, int n_in, void* d_out, int out_size, void* d_ws, size_t ws_size, hipStream_t stream) {
    static int grid = 0;
    if (grid == 0) {
        if (n_in != 14 || in_sizes[0] != M * D || out_size != M * D || ws_size < WS_END) { fprintf(stderr, "kernel_launch: unexpected shapes: n_in %d in0 %d out %d ws %zu\n", n_in, n_in > 0 ? in_sizes[0] : -1, out_size, ws_size); grid = -1; return; }
        int dev = 0, cus = 0, per_cu = 0;
        if (hipGetDevice(&dev) != hipSuccess || hipDeviceGetAttribute(&cus, hipDeviceAttributeMultiprocessorCount, dev) != hipSuccess) { grid = -1; return; }
        if (hipFuncSetAttribute((const void*)mk_fwd, hipFuncAttributeMaxDynamicSharedMemorySize, LDS_BYTES) != hipSuccess) { fprintf(stderr, "kernel_launch: hipFuncSetAttribute failed\n"); grid = -1; return; }
        if (hipOccupancyMaxActiveBlocksPerMultiprocessor(&per_cu, (const void*)mk_fwd, NWAVES * 64, LDS_BYTES) != hipSuccess || per_cu < 1)
            fprintf(stderr, "kernel_launch: note: occupancy query reports %d workgroups per CU\n", per_cu);
        (void)hipGetLastError();
        grid = cus;
    }
    if (grid < 0) return;
    if (hipMemsetAsync((char*)d_ws + WS_CTL, 0, CTL_ZERO_BYTES, stream) != hipSuccess) { fprintf(stderr, "kernel_launch: hipMemsetAsync failed\n"); return; }
    Args a{};
    for (int i = 0; i < 14; ++i) a.in[i] = (const float*)d_in[i];
    a.out = (float*)d_out; a.ws = (unsigned char*)d_ws;
    if (N_LAUNCHES == PER_PHASE) {
        for (int li = 0; li < PER_PHASE; ++li) { a.ph_lo = li; a.ph_hi = li + 1; a.li = li; hipLaunchKernelGGL(mk_fwd, dim3(grid), dim3(NWAVES * 64), LDS_BYTES, stream, a); }
    } else {
        a.ph_lo = 0; a.ph_hi = PER_PHASE; a.li = 0;
        hipLaunchKernelGGL(mk_fwd, dim3(grid), dim3(NWAVES * 64), LDS_BYTES, stream, a);
    }
    const hipError_t le = hipPeekAtLastError();
    if (le != hipSuccess) fprintf(stderr, "kernel_launch: launch failed: %s\n", hipGetErrorName(le));
}
```
